# Optimizing an MI355X kernel written in HIP

```python
import math
import jax, jax.numpy as jnp
from jax import lax
import numpy as np

D_MODEL = 1024
BATCH = 1
SEQ = 16384
DEPTH = 4

GRID_W = 64
CTX_LEN = 256
EPS = 1e-6

SSD_HEADS = 4
SSD_HEAD_DIM = 64
SSD_INNER = SSD_HEADS * SSD_HEAD_DIM
SSD_GROUPS = 2
SSD_STATE = 64
SSD_CONV = 3
SSD_CHUNK = 128
SSD_CONV_DIM = SSD_INNER + 2 * SSD_GROUPS * SSD_STATE

S5_WIDTH = 256
S5_GROUP = 16
S5_GROUPS = S5_WIDTH // S5_GROUP
S5_STATE = 64

DA_HEADS = 8
DA_HEAD_DIM = 32
DA_V_DIM = 2 * DA_HEAD_DIM
DA_WIDTH = DA_HEADS * DA_V_DIM
DA_QK_WIDTH = DA_HEADS * 2 * DA_HEAD_DIM
Q_BLOCK = 128
ROPE_THETA = 10000.0
ROPE_FREQS = DA_HEAD_DIM // 4

MIX_WIDTH = SSD_INNER + S5_WIDTH + DA_WIDTH
IN_SSD = SSD_INNER + SSD_CONV_DIM + 2 * SSD_HEADS
IN_S5 = S5_WIDTH
IN_DA = 2 * DA_QK_WIDTH + DA_WIDTH
IN_WIDTH = IN_SSD + IN_S5 + IN_DA

D_FF = ((8 * D_MODEL // 3 + 255) // 256) * 256

kernel_name = "hybrid_ssd_s5_diffattn_prefix_dit"


def rmsnorm(x, g):
    xf = x.astype(jnp.float32)
    y = xf * lax.rsqrt(jnp.mean(xf * xf, axis=-1, keepdims=True) + EPS) * g.astype(jnp.float32)
    return y.astype(x.dtype)


def dwconv(x, w, b):
    out = lax.conv_general_dilated(x, w[:, None, :], window_strides=(1,), padding='SAME',
                                   dimension_numbers=('NWC', 'WIO', 'NWC'),
                                   feature_group_count=x.shape[-1])
    return out + b


def segsum(a):
    t = a.shape[-1]
    cs = jnp.cumsum(a, axis=-1)
    diff = cs[..., :, None] - cs[..., None, :]
    return jnp.where(jnp.tril(jnp.ones((t, t), bool)), diff, -jnp.inf)


def ssd_scan(x, dt, a, b_in, c_in, h0):
    bsz, L, H, P = x.shape
    nc = L // SSD_CHUNK
    rep = H // b_in.shape[2]
    bh = jnp.repeat(b_in, rep, axis=2).reshape(bsz, nc, SSD_CHUNK, H, -1)
    ch = jnp.repeat(c_in, rep, axis=2).reshape(bsz, nc, SSD_CHUNK, H, -1)
    xd = (x * dt[..., None]).reshape(bsz, nc, SSD_CHUNK, H, P)
    a_dt = (dt * a).reshape(bsz, nc, SSD_CHUNK, H).transpose(0, 3, 1, 2)
    a_cs = jnp.cumsum(a_dt, axis=-1)
    decay = jnp.exp(segsum(a_dt))
    y_diag = jnp.einsum('bclhn,bcshn,bhcls,bcshp->bclhp', ch, bh, decay, xd)
    decay_states = jnp.exp(a_cs[..., -1:] - a_cs)
    states = jnp.einsum('bclhn,bhcl,bclhp->bchpn', bh, decay_states, xd)
    chunk_decay = jnp.exp(a_cs[..., -1])

    def step(s, inp):
        st, dec = inp
        return s * dec[..., None, None] + st, s

    final, prev = lax.scan(step, h0, (states.transpose(1, 0, 2, 3, 4), chunk_decay.transpose(2, 0, 1)))
    prev = prev.transpose(1, 0, 2, 3, 4)
    y_off = jnp.einsum('bclhn,bchpn,bhcl->bclhp', ch, prev, jnp.exp(a_cs))
    return (y_diag + y_off).reshape(bsz, L, H, P), final


def ssd_branch(p, conv_w, conv_b, a_log, dt_bias, d_skip, norm_g, h0_fwd, h0_bwd):
    bsz, L, _ = p.shape
    z, xbc, dt = jnp.split(p, [SSD_INNER, SSD_INNER + SSD_CONV_DIM], axis=-1)
    xbc = jax.nn.silu(dwconv(xbc, conv_w, conv_b)).astype(jnp.float32)
    xs, bs, cs = jnp.split(xbc, [SSD_INNER, SSD_INNER + SSD_GROUPS * SSD_STATE], axis=-1)
    xs = xs.reshape(bsz, L, SSD_HEADS, SSD_HEAD_DIM)
    bs = bs.reshape(bsz, L, SSD_GROUPS, SSD_STATE)
    cs = cs.reshape(bsz, L, SSD_GROUPS, SSD_STATE)
    dt = jax.nn.softplus(dt.astype(jnp.float32).reshape(bsz, L, 2, SSD_HEADS) + dt_bias.astype(jnp.float32))
    a = -jnp.exp(a_log.astype(jnp.float32))
    rev = lambda t: t[:, ::-1]
    y_f, s_f = ssd_scan(xs, dt[:, :, 0], a[0], bs, cs, h0_fwd)
    y_b, s_b = ssd_scan(rev(xs), rev(dt[:, :, 1]), a[1], rev(bs), rev(cs), h0_bwd)
    y = y_f + rev(y_b) + d_skip.astype(jnp.float32)[:, None] * xs
    y = y.reshape(bsz, L, SSD_INNER) * jax.nn.silu(z.astype(jnp.float32))
    return rmsnorm(y, norm_g).astype(p.dtype), s_f, s_b


def s5_direction(ug, lam_re, lam_im, log_step, b_re, b_im, c_re, c_im, h0):
    lam = lax.complex(lam_re.astype(jnp.float32), lam_im.astype(jnp.float32))
    step = jnp.exp(log_step.astype(jnp.float32))[:, None]
    lam_bar = jnp.exp(lam * step)
    b = lax.complex(b_re.astype(jnp.float32), b_im.astype(jnp.float32))
    b_bar = ((lam_bar - 1.0) / lam)[..., None] * b
    cm = lax.complex(c_re.astype(jnp.float32), c_im.astype(jnp.float32))
    bu = jnp.einsum('blgc,gpc->blgp', ug, b_bar)
    bu = bu.at[:, 0].add(lam_bar * h0)
    lam_seq = jnp.broadcast_to(lam_bar, bu.shape)

    def combine(e1, e2):
        a1, v1 = e1
        a2, v2 = e2
        return a1 * a2, a2 * v1 + v2

    _, states = lax.associative_scan(combine, (lam_seq, bu), axis=1)
    y = jnp.einsum('blgp,gcp->blgc', states, cm).real
    return y, states[:, -1]


def s5_branch(u, lam_re, lam_im, log_step, b_re, b_im, c_re, c_im, d_skip, glu_w, glu_b, h0_fwd, h0_bwd):
    bsz, L, _ = u.shape
    uf = u.astype(jnp.float32)
    ug = uf.reshape(bsz, L, S5_GROUPS, S5_GROUP)
    y_f, t_f = s5_direction(ug, lam_re[0], lam_im[0], log_step[0], b_re[0], b_im[0], c_re[0], c_im[0], h0_fwd)
    y_b, t_b = s5_direction(ug[:, ::-1], lam_re[1], lam_im[1], log_step[1], b_re[1], b_im[1], c_re[1], c_im[1], h0_bwd)
    y = (y_f + y_b[:, ::-1]).reshape(bsz, L, S5_WIDTH) + d_skip.astype(jnp.float32) * uf
    y = jax.nn.gelu(y)
    y = y * jax.nn.sigmoid(y @ glu_w.astype(jnp.float32) + glu_b.astype(jnp.float32))
    return y.astype(u.dtype), t_f, t_b


def axial_rope_tables(row, col):
    freqs = ROPE_THETA ** (-jnp.arange(ROPE_FREQS, dtype=jnp.float32) / ROPE_FREQS)
    ang = jnp.stack([row.astype(jnp.float32)[:, None] * freqs,
                     col.astype(jnp.float32)[:, None] * freqs], axis=1)
    return jnp.cos(ang), jnp.sin(ang)


def apply_rope(x, cos, sin):
    xr = x.astype(jnp.float32).reshape(*x.shape[:-1], 2, 2, ROPE_FREQS)
    x1, x2 = xr[..., 0, :], xr[..., 1, :]
    cb, sb = cos[:, None, None], sin[:, None, None]
    out = jnp.stack([x1 * cb - x2 * sb, x1 * sb + x2 * cb], axis=-2)
    return out.reshape(x.shape).astype(x.dtype)


def diff_attend(q, k, v, lam):
    s = jnp.einsum('bqhcd,bkhcd->bhcqk', q, k).astype(jnp.float32) * (DA_HEAD_DIM ** -0.5)
    pr = jax.nn.softmax(s, axis=-1)
    a = pr[:, :, 0] - lam * pr[:, :, 1]
    return jnp.einsum('bhqk,bkhe->bqhe', a.astype(v.dtype), v)


def diffattn_branch(p_l, p_c, q_norm, k_norm, lam_vec, sub_norm, cos, sin, lam_init):
    def qkv(p):
        bsz, L, _ = p.shape
        q, k, v = jnp.split(p, [DA_QK_WIDTH, 2 * DA_QK_WIDTH], axis=-1)
        q = rmsnorm(q.reshape(bsz, L, DA_HEADS, 2, DA_HEAD_DIM), q_norm)
        k = rmsnorm(k.reshape(bsz, L, DA_HEADS, 2, DA_HEAD_DIM), k_norm)
        return q, k, v.reshape(bsz, L, DA_HEADS, DA_V_DIM)

    q_c, k_c, v_c = qkv(p_c)
    q_l, k_l, v_l = qkv(p_l)
    q_l = apply_rope(q_l, cos, sin)
    k_l = apply_rope(k_l, cos, sin)
    lf = lam_vec.astype(jnp.float32)
    lam = jnp.exp(jnp.sum(lf[0] * lf[1])) - jnp.exp(jnp.sum(lf[2] * lf[3])) + lam_init

    o_c = diff_attend(q_c, k_c, v_c, lam)
    k_all = jnp.concatenate([k_c, k_l], axis=1)
    v_all = jnp.concatenate([v_c, v_l], axis=1)
    bsz, L = q_l.shape[:2]
    qb = q_l.reshape(bsz, L // Q_BLOCK, Q_BLOCK, DA_HEADS, 2, DA_HEAD_DIM).transpose(1, 0, 2, 3, 4, 5)
    o_l = lax.map(lambda qq: diff_attend(qq, k_all, v_all, lam), qb)
    o_l = o_l.transpose(1, 0, 2, 3, 4).reshape(bsz, L, DA_HEADS, DA_V_DIM)

    def post(o):
        return (rmsnorm(o, sub_norm) * (1.0 - lam_init)).reshape(o.shape[0], o.shape[1], DA_WIDTH)

    return post(o_l), post(o_c)


def token_mixer(h_l, h_c, w_in, w_out, ssd_p, s5_p, da_p, cos, sin, lam_init):
    p_l = h_l @ w_in
    p_c = h_c @ w_in
    cuts = [IN_SSD, IN_SSD + IN_S5]
    ssd_l, s5_l, da_l = jnp.split(p_l, cuts, axis=-1)
    ssd_c, s5_c, da_c = jnp.split(p_c, cuts, axis=-1)
    bsz = p_l.shape[0]

    z_ssd = jnp.zeros((bsz, SSD_HEADS, SSD_HEAD_DIM, SSD_STATE), jnp.float32)
    y_ssd_c, sf, sb = ssd_branch(ssd_c, *ssd_p, z_ssd, z_ssd)
    y_ssd_l, _, _ = ssd_branch(ssd_l, *ssd_p, sf, sb)

    z_s5 = jnp.zeros((bsz, S5_GROUPS, S5_STATE), jnp.complex64)
    y_s5_c, tf, tb = s5_branch(s5_c, *s5_p, z_s5, z_s5)
    y_s5_l, _, _ = s5_branch(s5_l, *s5_p, tf, tb)

    y_da_l, y_da_c = diffattn_branch(da_l, da_c, *da_p, cos, sin, lam_init)

    o_l = jnp.concatenate([y_ssd_l, y_s5_l, y_da_l.astype(y_ssd_l.dtype)], axis=-1) @ w_out
    o_c = jnp.concatenate([y_ssd_c, y_s5_c, y_da_c.astype(y_ssd_c.dtype)], axis=-1) @ w_out
    return o_l, o_c


def swiglu(h, w1, w3, w2):
    return (jax.nn.silu(h @ w1) * (h @ w3)) @ w2


def setup_inputs(seed: int = 0) -> dict:
    key = jax.random.key(seed)
    ks = iter(jax.random.split(key, 48))
    f32 = jnp.float32

    def nrm(shape, scale):
        return scale * jax.random.normal(next(ks), shape, f32)

    def uni(shape, lo, hi):
        return jax.random.uniform(next(ks), shape, f32, lo, hi)

    x = nrm((BATCH, SEQ, D_MODEL), 1.0)
    c = nrm((BATCH, D_MODEL), 1.0)
    ctx = nrm((BATCH, CTX_LEN, D_MODEL), 1.0)
    c_ctx = nrm((D_MODEL,), 1.0)
    w_mod = nrm((DEPTH, D_MODEL, 6 * D_MODEL), 0.5 * D_MODEL ** -0.5)
    b_mod = nrm((DEPTH, 6 * D_MODEL), 0.02)
    norm1 = 1.0 + nrm((DEPTH, D_MODEL), 0.02)
    norm2 = 1.0 + nrm((DEPTH, D_MODEL), 0.02)
    w_in = nrm((DEPTH, D_MODEL, IN_WIDTH), D_MODEL ** -0.5)
    w_out = nrm((DEPTH, MIX_WIDTH, D_MODEL), MIX_WIDTH ** -0.5)
    ssd_conv_w = nrm((DEPTH, SSD_CONV, SSD_CONV_DIM), SSD_CONV ** -0.5)
    ssd_conv_b = nrm((DEPTH, SSD_CONV_DIM), 0.02)
    ssd_a_log = jnp.log(uni((DEPTH, 2, SSD_HEADS), 1.0, 16.0))
    dt0 = jnp.exp(uni((DEPTH, 2, SSD_HEADS), math.log(1e-3), math.log(1e-1)))
    ssd_dt_bias = dt0 + jnp.log(-jnp.expm1(-dt0))
    ssd_d = 1.0 + nrm((DEPTH, SSD_HEADS), 0.1)
    ssd_norm = 1.0 + nrm((DEPTH, SSD_INNER), 0.02)
    n_idx = jnp.arange(S5_STATE, dtype=f32)
    s5_lam_re = -0.5 + nrm((DEPTH, 2, S5_GROUPS, S5_STATE), 0.01)
    s5_lam_im = math.pi * n_idx + nrm((DEPTH, 2, S5_GROUPS, S5_STATE), 0.01)
    s5_log_step = uni((DEPTH, 2, S5_GROUPS), math.log(1e-3), math.log(1e-1))
    s5_b_re = nrm((DEPTH, 2, S5_GROUPS, S5_STATE, S5_GROUP), (2 * S5_GROUP) ** -0.5)
    s5_b_im = nrm((DEPTH, 2, S5_GROUPS, S5_STATE, S5_GROUP), (2 * S5_GROUP) ** -0.5)
    s5_c_re = nrm((DEPTH, 2, S5_GROUPS, S5_GROUP, S5_STATE), S5_STATE ** -0.5)
    s5_c_im = nrm((DEPTH, 2, S5_GROUPS, S5_GROUP, S5_STATE), S5_STATE ** -0.5)
    s5_d = nrm((DEPTH, S5_WIDTH), 1.0)
    s5_glu_w = nrm((DEPTH, S5_WIDTH, S5_WIDTH), S5_WIDTH ** -0.5)
    s5_glu_b = nrm((DEPTH, S5_WIDTH), 0.02)
    da_q_norm = 1.0 + nrm((DEPTH, DA_HEAD_DIM), 0.02)
    da_k_norm = 1.0 + nrm((DEPTH, DA_HEAD_DIM), 0.02)
    da_lambda = nrm((DEPTH, 4, DA_HEAD_DIM), 0.1)
    da_sub_norm = 1.0 + nrm((DEPTH, DA_V_DIM), 0.02)
    ffn_w1 = nrm((DEPTH, D_MODEL, D_FF), D_MODEL ** -0.5)
    ffn_w3 = nrm((DEPTH, D_MODEL, D_FF), D_MODEL ** -0.5)
    ffn_w2 = nrm((DEPTH, D_FF, D_MODEL), D_FF ** -0.5)
    return {"x": x, "c": c, "ctx": ctx, "c_ctx": c_ctx,
            "w_mod": w_mod, "b_mod": b_mod, "norm1": norm1, "norm2": norm2,
            "w_in": w_in, "w_out": w_out,
            "ssd_conv_w": ssd_conv_w, "ssd_conv_b": ssd_conv_b, "ssd_a_log": ssd_a_log,
            "ssd_dt_bias": ssd_dt_bias, "ssd_d": ssd_d, "ssd_norm": ssd_norm,
            "s5_lam_re": s5_lam_re, "s5_lam_im": s5_lam_im, "s5_log_step": s5_log_step,
            "s5_b_re": s5_b_re, "s5_b_im": s5_b_im, "s5_c_re": s5_c_re, "s5_c_im": s5_c_im,
            "s5_d": s5_d, "s5_glu_w": s5_glu_w, "s5_glu_b": s5_glu_b,
            "da_q_norm": da_q_norm, "da_k_norm": da_k_norm, "da_lambda": da_lambda,
            "da_sub_norm": da_sub_norm,
            "ffn_w1": ffn_w1, "ffn_w3": ffn_w3, "ffn_w2": ffn_w2}


def reference(x, c, ctx, c_ctx, w_mod, b_mod, norm1, norm2, w_in, w_out,
              ssd_conv_w, ssd_conv_b, ssd_a_log, ssd_dt_bias, ssd_d, ssd_norm,
              s5_lam_re, s5_lam_im, s5_log_step, s5_b_re, s5_b_im, s5_c_re, s5_c_im,
              s5_d, s5_glu_w, s5_glu_b,
              da_q_norm, da_k_norm, da_lambda, da_sub_norm,
              ffn_w1, ffn_w3, ffn_w2):
    L = x.shape[1]
    rows = L // GRID_W
    row = jnp.repeat(jnp.arange(rows), GRID_W)
    col = jnp.tile(jnp.arange(GRID_W), rows)
    cos, sin = axial_rope_tables(row, col)
    cx = ctx
    for i in range(DEPTH):
        mod_l = (jax.nn.silu(c) @ w_mod[i] + b_mod[i])[:, None, :]
        mod_c = jax.nn.silu(c_ctx) @ w_mod[i] + b_mod[i]
        sh1_l, sc1_l, g1_l, sh2_l, sc2_l, g2_l = jnp.split(mod_l, 6, axis=-1)
        sh1_c, sc1_c, g1_c, sh2_c, sc2_c, g2_c = jnp.split(mod_c, 6, axis=-1)
        lam_init = 0.8 - 0.6 * math.exp(-0.3 * i)

        h_l = rmsnorm(x, norm1[i]) * (1.0 + sc1_l) + sh1_l
        h_c = rmsnorm(cx, norm1[i]) * (1.0 + sc1_c) + sh1_c
        ssd_p = (ssd_conv_w[i], ssd_conv_b[i], ssd_a_log[i], ssd_dt_bias[i], ssd_d[i], ssd_norm[i])
        s5_p = (s5_lam_re[i], s5_lam_im[i], s5_log_step[i], s5_b_re[i], s5_b_im[i],
                s5_c_re[i], s5_c_im[i], s5_d[i], s5_glu_w[i], s5_glu_b[i])
        da_p = (da_q_norm[i], da_k_norm[i], da_lambda[i], da_sub_norm[i])
        o_l, o_c = token_mixer(h_l, h_c, w_in[i], w_out[i], ssd_p, s5_p, da_p, cos, sin, lam_init)
        x = x + g1_l * o_l
        h2_l = rmsnorm(x, norm2[i]) * (1.0 + sc2_l) + sh2_l
        x = x + g2_l * swiglu(h2_l, ffn_w1[i], ffn_w3[i], ffn_w2[i])
        if i < DEPTH - 1:
            cx = cx + g1_c * o_c
            h2_c = rmsnorm(cx, norm2[i]) * (1.0 + sc2_c) + sh2_c
            cx = cx + g2_c * swiglu(h2_c, ffn_w1[i], ffn_w3[i], ffn_w2[i])
    return x
```

```cpp
#include <hip/hip_runtime.h>
#include <hip/hip_cooperative_groups.h>
#include <cstdio>
#include <cstdint>
#include <cmath>
#include <cstddef>
namespace cg = cooperative_groups;
__device__ __forceinline__ int lt_tid() { int t = threadIdx.x; asm volatile("" : "+v"(t)); return t; }
__device__ __forceinline__ int lt_bid() { int t = blockIdx.x; asm volatile("" : "+s"(t)); return t; }
__device__ __forceinline__ int lt_grid() { int t = gridDim.x; asm volatile("" : "+s"(t)); return t; }
namespace pg8 {
#define PG8_LAS __attribute__((address_space(3)))
typedef unsigned short bf16_t;
typedef short bf16x8 __attribute__((ext_vector_type(8)));
typedef float f32x4 __attribute__((ext_vector_type(4)));
typedef unsigned u32x4 __attribute__((ext_vector_type(4)));
constexpr int BM = 256, BK = 64, HALF = 128, HTB = HALF * BK * 2  , STAGE_BYTES = 8 * HTB, NXCD = 8, WGM = 8;

__host__ __device__ __forceinline__ int lds_byte(int r, int c) { const int st = (r >> 4) * 2 + (c >> 5), rr = r & 15, cc = c & 31, ob = rr * 64 + cc * 2; return st * 1024 + (ob ^ (((ob >> 9) & 1) << 5)); }
__host__ __device__ __forceinline__ void stage_rc(int b, int& R, int& C) { const int st = b / 1024, sb = b % 1024, swz = sb ^ (((sb >> 9) & 1) << 5); R = (st >> 1) * 16 + swz / 64; C = (st & 1) * 32 + (swz % 64) / 2; }
__host__ __device__ __forceinline__ int perm32(int rho) { const int n = rho >> 4, i = rho & 15; return 8 * (i >> 2) + 4 * n + (i & 3); }

struct Unit { int pm, pn, k0, nkt; };
struct Gemm { const bf16_t* A; const bf16_t* Bt; int M, N, K; };

struct StaticOrder {
    int nM, nN, nwg, G, c, nkt;
    __host__ __device__ void init(int M, int N, int G_, int c_) { nM = M / BM; nN = N / BM; nwg = nM * nN; G = G_; c = c_; }
    __host__ __device__ bool next(int i, Unit& u) const {
        const long L = (long)i * G + c; if (L >= nwg) return false;
        int wgid = (int)L; { const int q = nwg / NXCD, r = nwg % NXCD, xcd = wgid % NXCD, off = wgid / NXCD; wgid = (xcd < r ? xcd * (q + 1) : r * (q + 1) + (xcd - r) * q) + off; }
        const int nig = WGM * nN, gid = wgid / nig, fm = gid * WGM, gsz = (nM - fm) < WGM ? (nM - fm) : WGM;
        u.pm = fm + ((wgid % nig) % gsz); u.pn = (wgid % nig) / gsz; u.k0 = 0; u.nkt = nkt; return true;
    }
    __device__ __forceinline__ void a_ready(const Unit&) const {}
    __device__ __forceinline__ void done(const Unit&) const {}
};

__device__ __forceinline__ unsigned cvt_pk_bf16(float lo, float hi) { unsigned r; asm volatile("v_cvt_pk_bf16_f32 %0, %1, %2" : "=v"(r) : "v"(lo), "v"(hi)); return r; }
typedef float f32x2 __attribute__((ext_vector_type(2)));
template <class Epi, class Sched, bool ALIGN_EPI = false, bool SP2 = false>
__device__ __forceinline__ void gemm_phase(PG8_LAS unsigned char* lds, const Gemm g, const Sched& S, const Epi& E) {
    const int tid = lt_tid(), wid = __builtin_amdgcn_readfirstlane(tid >> 6), lane = tid & 63, wr = wid >> 2, wc = wid & 3, fr = lane & 15, fq = lane >> 4;
    int K = g.K; asm volatile("" : "+s"(K));
    unsigned voffA[2], voffB[2];
#pragma unroll
    for (int i = 0; i < 2; ++i) { int R, C; stage_rc(tid * 16 + i * 8192, R, C); const int Rb = Epi::PERM ? ((R & ~31) + perm32(R & 31)) : R;
        voffA[i] = (unsigned)(R * K + C) * 2u; voffB[i] = (unsigned)(Rb * K + C) * 2u; }
    const size_t kstep = (size_t)(BK * 2);
    const size_t hstep = (size_t)HALF * K * 2;
    const size_t tstep = 2 * hstep;
    const unsigned ldsw = (unsigned)wid * 1024u;
    const int aoff = lds_byte(wr * 64 + fr, fq * 8), boff = lds_byte(wc * 32 + fr, fq * 8);
#define PG8_SA(b, h) (((b) * 2 + (h)) * HTB)
#define PG8_SB(b, h) ((4 + (b) * 2 + (h)) * HTB)
#define PG8_STAGE(bufoff, gbase, voff) do { _Pragma("unroll") for (int _i = 0; _i < 2; ++_i) \
        __builtin_amdgcn_global_load_lds((const unsigned*)((const char*)(gbase) + (voff)[_i]), (PG8_LAS unsigned*)(lds + (bufoff) + ldsw + _i * 8192), 16, 0, 0); } while (0)
#define PG8_LDA(dst, b, h) do { _Pragma("unroll") for (int m = 0; m < 4; ++m) _Pragma("unroll") for (int k = 0; k < 2; ++k) dst[m][k] = *(const PG8_LAS bf16x8*)(lds + PG8_SA(b, h) + aoff + m * 2048 + k * 1024); } while (0)
#define PG8_LDB(dst, b, h) do { _Pragma("unroll") for (int n = 0; n < 2; ++n) _Pragma("unroll") for (int k = 0; k < 2; ++k) dst[n][k] = *(const PG8_LAS bf16x8*)(lds + PG8_SB(b, h) + boff + n * 2048 + k * 1024); } while (0)
#define PG8_MMA(ai, bj, At, Bt) do { __builtin_amdgcn_s_setprio(1); _Pragma("unroll") for (int m = 0; m < 4; ++m) _Pragma("unroll") for (int n = 0; n < 2; ++n) _Pragma("unroll") for (int k = 0; k < 2; ++k) \
        acc[ai][bj][m][n] = __builtin_amdgcn_mfma_f32_16x16x32_bf16(Bt[n][k], At[m][k], acc[ai][bj][m][n], 0, 0, 0); __builtin_amdgcn_s_setprio(0); } while (0)
#define PG8_WAIT_V(n) asm volatile("s_waitcnt vmcnt(" #n ")" ::: "memory")
#define PG8_WAIT_L(n) asm volatile("s_waitcnt lgkmcnt(" #n ")" ::: "memory")
#define PG8_BAR __builtin_amdgcn_s_barrier()
#define PG8_SCHED __builtin_amdgcn_sched_barrier(0)
    Unit cur, nxt; int ui = 0;
    if (!S.next(0, cur)) return;
    f32x4 acc[2][2][4][2];
#pragma unroll
    for (int a = 0; a < 2; ++a)
#pragma unroll
        for (int b = 0; b < 2; ++b)
#pragma unroll
            for (int m = 0; m < 4; ++m)
#pragma unroll
                for (int n = 0; n < 2; ++n) acc[a][b][m][n] = (f32x4){0.f, 0.f, 0.f, 0.f};
    bf16x8 At[4][2], B0[2][2], B1[2][2];
    const char* cA = (const char*)g.A + (size_t)cur.pm * tstep + (size_t)cur.k0 * 2; const char* cB = (const char*)g.Bt + (size_t)cur.pn * tstep + (size_t)cur.k0 * 2;
    S.a_ready(cur);
    if constexpr (SP2) {
        PG8_STAGE(PG8_SB(0, 0), cB, voffB); PG8_STAGE(PG8_SB(0, 1), cB + hstep, voffB); PG8_STAGE(PG8_SA(0, 0), cA, voffA); PG8_STAGE(PG8_SA(0, 1), cA + hstep, voffA);
        if (wr == 1) PG8_BAR;
        PG8_WAIT_V(2); PG8_BAR;
        PG8_STAGE(PG8_SB(1, 0), cB + kstep, voffB); PG8_STAGE(PG8_SA(1, 0), cA + kstep, voffA); PG8_STAGE(PG8_SB(1, 1), cB + hstep + kstep, voffB);
        PG8_WAIT_V(6); PG8_BAR;
    } else {
        PG8_STAGE(PG8_SB(0, 0), cB, voffB); PG8_STAGE(PG8_SA(0, 0), cA, voffA); PG8_STAGE(PG8_SB(0, 1), cB + hstep, voffB); PG8_STAGE(PG8_SA(0, 1), cA + hstep, voffA);
        if (wr == 1) PG8_BAR;
        PG8_WAIT_V(4); PG8_BAR;
        PG8_STAGE(PG8_SB(1, 0), cB + kstep, voffB); PG8_STAGE(PG8_SA(1, 0), cA + kstep, voffA); PG8_STAGE(PG8_SB(1, 1), cB + hstep + kstep, voffB);
        PG8_WAIT_V(6); PG8_BAR;
    }
    for (;;) {
        const bool has_next = S.next(ui + 1, nxt);
        const char* nA = has_next ? (const char*)g.A + (size_t)nxt.pm * tstep + (size_t)nxt.k0 * 2 : cA; const char* nB = has_next ? (const char*)g.Bt + (size_t)nxt.pn * tstep + (size_t)nxt.k0 * 2 : cB;
        const int nt = cur.nkt;
        for (int t = 0; t < nt; t += 2) {
            const bool last = (t == nt - 2);
            const char* a1 = cA + (size_t)(t + 1) * kstep;
            const char* a2 = last ? nA : cA + (size_t)(t + 2) * kstep; const char* b2 = last ? nB : cB + (size_t)(t + 2) * kstep;
            const char* a3 = a2 + kstep; const char* b3 = b2 + kstep;
            if (last && has_next) S.a_ready(nxt);
            if constexpr (SP2) {
            PG8_LDB(B0, 0, 0); PG8_LDB(B1, 0, 1); PG8_SCHED; PG8_LDA(At, 0, 0); PG8_STAGE(PG8_SA(1, 1), a1 + hstep, voffA);
            PG8_WAIT_V(8); PG8_WAIT_L(0); PG8_BAR; PG8_MMA(0, 0, At, B0); PG8_MMA(0, 1, At, B1); PG8_BAR; PG8_SCHED;
            PG8_LDA(At, 0, 1); PG8_STAGE(PG8_SB(0, 0), b2, voffB); PG8_STAGE(PG8_SB(0, 1), b2 + hstep, voffB); PG8_STAGE(PG8_SA(0, 0), a2, voffA);
            PG8_WAIT_V(8); PG8_WAIT_L(0); PG8_BAR; PG8_MMA(1, 0, At, B0); PG8_MMA(1, 1, At, B1); PG8_BAR; PG8_SCHED;
            PG8_LDB(B0, 1, 0); PG8_LDB(B1, 1, 1); PG8_SCHED; PG8_LDA(At, 1, 0); PG8_STAGE(PG8_SA(0, 1), a2 + hstep, voffA);
            PG8_WAIT_V(8); PG8_WAIT_L(0); PG8_BAR; PG8_MMA(0, 0, At, B0); PG8_MMA(0, 1, At, B1); PG8_BAR; PG8_SCHED;
            PG8_LDA(At, 1, 1); PG8_STAGE(PG8_SB(1, 0), b3, voffB); PG8_STAGE(PG8_SB(1, 1), b3 + hstep, voffB); PG8_STAGE(PG8_SA(1, 0), a3, voffA);
            PG8_WAIT_V(8); PG8_WAIT_L(0); PG8_BAR; PG8_MMA(1, 0, At, B0); PG8_MMA(1, 1, At, B1); PG8_BAR; PG8_SCHED;
            } else {
            PG8_LDB(B0, 0, 0); PG8_SCHED; PG8_LDA(At, 0, 0); PG8_STAGE(PG8_SA(1, 1), a1 + hstep, voffA);
            PG8_WAIT_L(8); PG8_BAR; PG8_WAIT_L(0); PG8_MMA(0, 0, At, B0); PG8_BAR; PG8_SCHED;
            PG8_LDB(B1, 0, 1); PG8_STAGE(PG8_SB(0, 0), b2, voffB);
            PG8_BAR; PG8_WAIT_L(0); PG8_MMA(0, 1, At, B1); PG8_BAR;
            PG8_LDA(At, 0, 1); PG8_STAGE(PG8_SA(0, 0), a2, voffA);
            PG8_BAR; PG8_WAIT_L(0); PG8_MMA(1, 0, At, B0); PG8_BAR; PG8_SCHED;
            PG8_STAGE(PG8_SB(0, 1), b2 + hstep, voffB);
            PG8_WAIT_V(6); PG8_BAR; PG8_MMA(1, 1, At, B1); PG8_BAR;
            PG8_LDB(B0, 1, 0); PG8_SCHED; PG8_LDA(At, 1, 0); PG8_STAGE(PG8_SA(0, 1), a2 + hstep, voffA);
            PG8_WAIT_L(8); PG8_BAR; PG8_WAIT_L(0); PG8_MMA(0, 0, At, B0); PG8_BAR; PG8_SCHED;
            PG8_LDB(B1, 1, 1); PG8_STAGE(PG8_SB(1, 0), b3, voffB);
            PG8_BAR; PG8_WAIT_L(0); PG8_MMA(0, 1, At, B1); PG8_BAR;
            PG8_LDA(At, 1, 1); PG8_STAGE(PG8_SA(1, 0), a3, voffA);
            PG8_BAR; PG8_WAIT_L(0); PG8_MMA(1, 0, At, B0); PG8_BAR; PG8_SCHED;
            PG8_STAGE(PG8_SB(1, 1), b3 + hstep, voffB);
            PG8_WAIT_V(6); PG8_BAR; PG8_MMA(1, 1, At, B1); PG8_BAR;
            }
        }
        if constexpr (ALIGN_EPI) { if (wr == 0) PG8_BAR; }
        if constexpr (!Epi::AFTER_DRAIN) { E(acc, cur, wr, wc, fr, fq); S.done(cur); }
        if (!has_next) break;
#pragma unroll
        for (int a = 0; a < 2; ++a)
#pragma unroll
            for (int b = 0; b < 2; ++b)
#pragma unroll
                for (int m = 0; m < 4; ++m)
#pragma unroll
                    for (int n = 0; n < 2; ++n) acc[a][b][m][n] = (f32x4){0.f, 0.f, 0.f, 0.f};
        cur = nxt; cA = nA; cB = nB; ++ui;
        if constexpr (ALIGN_EPI) { if (wr == 1) PG8_BAR; }
    }
    PG8_WAIT_V(0);
    if constexpr (!ALIGN_EPI) { if (wr == 0) PG8_BAR; }
    PG8_BAR;
    if constexpr (Epi::AFTER_DRAIN) { E.fused(acc, cur, wr, wc, fr, fq, lds, wid, lane); S.done(cur); }
#undef PG8_SA
#undef PG8_SB
#undef PG8_STAGE
#undef PG8_LDA
#undef PG8_LDB
#undef PG8_MMA
#undef PG8_WAIT_V
#undef PG8_WAIT_L
#undef PG8_BAR
#undef PG8_SCHED
}
}

#define LAS __attribute__((address_space(3)))
typedef unsigned short bf16;
typedef short bf16x8 __attribute__((ext_vector_type(8)));
typedef short s16x4 __attribute__((ext_vector_type(4)));
typedef short v4i16_t __attribute__((ext_vector_type(4)));
typedef float f32x2 __attribute__((ext_vector_type(2)));
typedef float f32x4 __attribute__((ext_vector_type(4)));
typedef float f32x16 __attribute__((ext_vector_type(16)));
typedef unsigned u32x2 __attribute__((ext_vector_type(2)));
typedef unsigned u32x4 __attribute__((ext_vector_type(4)));
typedef __bf16 bf16x2_t __attribute__((ext_vector_type(2)));

constexpr int DM = 1024, SEQ = 16384, CTX = 256, MR = SEQ + CTX, DEPTH = 4;
constexpr int NIN = 2816, INW = 2568, DFF = 2816, NFF2 = 5632;
constexpr float EPS = 1e-6f;
constexpr int NCH = MR / 64;
constexpr int NC5 = MR / 16;
constexpr int NTHREADS = 512;
constexpr int LDS_BYTES = 147456;

constexpr size_t al256(size_t x) { return (x + 255) & ~(size_t)255; }
constexpr size_t SZ_WIN = (size_t)NIN * DM * 2, SZ_WOUT = (size_t)DM * DM * 2, SZ_W13 = (size_t)NFF2 * DM * 2, SZ_W2 = (size_t)DM * DFF * 2, SZ_GLU = 256 * 256 * 2;
constexpr size_t SZ_BTE = (size_t)16 * 256 * 256 * 2, SZ_BTY = (size_t)16 * 256 * 512 * 2;
constexpr size_t OFF_WIN = 0;
constexpr size_t OFF_WOUT = OFF_WIN + DEPTH * SZ_WIN;
constexpr size_t OFF_W13 = OFF_WOUT + DEPTH * SZ_WOUT;
constexpr size_t OFF_W2 = OFF_W13 + DEPTH * SZ_W13;
constexpr size_t OFF_GLU = OFF_W2 + DEPTH * SZ_W2;
constexpr size_t OFF_BTE = OFF_GLU + DEPTH * SZ_GLU;
constexpr size_t OFF_BTY = OFF_BTE + DEPTH * SZ_BTE;
constexpr size_t OFF_KF = OFF_BTY + DEPTH * SZ_BTY;
constexpr size_t OFF_LAMT = OFF_KF + (size_t)DEPTH * 2 * 16 * 4096 * 4;
constexpr size_t OFF_POWT = OFF_LAMT + (size_t)DEPTH * 2 * 16 * 64 * 2 * 4;
constexpr size_t OFF_QF = OFF_POWT + (size_t)DEPTH * 2 * 16 * 64 * 17 * 2 * 4;
constexpr size_t OFF_MODP = OFF_QF + (size_t)DEPTH * 2 * 16 * 64 * 2 * 4;
constexpr size_t OFF_MOD = OFF_MODP + (size_t)DEPTH * 16 * 2 * 6144 * 4;
constexpr size_t OFF_ROPE = OFF_MOD + (size_t)DEPTH * 2 * 6144 * 4;
constexpr size_t OFF_XC = OFF_ROPE + 256 * 16 * 4;
constexpr size_t OFF_H = OFF_XC + (size_t)CTX * DM * 4;
constexpr size_t OFF_SST = OFF_H;
constexpr size_t OFF_ZB = OFF_H + (size_t)MR * DM * 2;
constexpr size_t OFF_XBC = OFF_ZB + (size_t)MR * 256 * 2;
constexpr size_t OFF_UB = OFF_XBC + (size_t)MR * 512 * 2;
constexpr size_t OFF_QB = OFF_UB + (size_t)MR * 256 * 2;
constexpr size_t OFF_KB = OFF_QB + (size_t)MR * 512 * 2;
constexpr size_t OFF_VB = OFF_KB + (size_t)MR * 512 * 2;
constexpr size_t OFF_DTB = OFF_VB + (size_t)MR * 512 * 2;
constexpr size_t OFF_MIX = OFF_DTB + (size_t)MR * 8 * 4;
constexpr size_t OFF_ACT_END = OFF_MIX + (size_t)MR * DM * 2;
constexpr size_t OFF_FFU = OFF_ZB;
static_assert(OFF_FFU + (size_t)MR * DFF * 2 <= OFF_ACT_END, "FFU overlay");
static_assert((size_t)NCH * 32768 * 4 <= (size_t)MR * DM * 2, "SST overlay");
constexpr size_t OFF_SENT = OFF_ACT_END;
constexpr size_t OFF_SDEC = OFF_SENT + (size_t)NCH * 32768 * 2;
constexpr size_t OFF_E = al256(OFF_SDEC + NCH * 8 * 4);
constexpr size_t OFF_XS = OFF_E + (size_t)NC5 * 4096 * 4;
constexpr size_t OFF_YG = OFF_XS + (size_t)NC5 * 4096 * 2;
constexpr size_t OFF_XACT = al256(OFF_YG + (size_t)MR * 256 * 2);
constexpr size_t OFF_BAR = al256(OFF_XACT + (size_t)MR * 512 * 2);
constexpr size_t BAR_BYTES = 16384;
constexpr size_t WS_END = OFF_BAR + BAR_BYTES;

struct Args {
    const float* in[33];
    float* out; unsigned char* ws;
    int ph_lo, ph_hi;
};
typedef const float* cfp_t;
typedef __attribute__((address_space(4))) const cfp_t* in_tab_t;
typedef float* fp_t; typedef unsigned char* ucp_t;
typedef __attribute__((address_space(4))) const fp_t* fpp_t; typedef __attribute__((address_space(4))) const ucp_t* ucpp_t;
struct PA { in_tab_t in; float* out; unsigned char* ws; };
enum { I_X = 0, I_C, I_CTX, I_CCTX, I_WMOD, I_BMOD, I_NORM1, I_NORM2, I_WIN, I_WOUT, I_CONVW, I_CONVB, I_ALOG, I_DTBIAS, I_SSDD, I_SSDNORM,
       I_LRE, I_LIM, I_LSTEP, I_BRE, I_BIM, I_CRE, I_CIM, I_S5D, I_GLUW, I_GLUB, I_QN, I_KN, I_DALAM, I_SUBN, I_W1, I_W3, I_W2 };

__device__ __forceinline__ unsigned cvtpk(float lo, float hi);
__device__ __forceinline__ unsigned f2bf(float f) { return cvtpk(f, 0.f) & 0xffffu; }
__device__ __forceinline__ float bf2f(unsigned short b) { return __builtin_bit_cast(float, (unsigned)b << 16); }
__device__ __forceinline__ unsigned cvtpk(float lo, float hi) { f32x2 v = {lo, hi}; bf16x2_t b = __builtin_convertvector(v, bf16x2_t); return __builtin_bit_cast(unsigned, b); }
__device__ __forceinline__ float wave_sum(float v) {
#pragma unroll
    for (int o = 1; o < 64; o <<= 1) v += __shfl_xor(v, o);
    return v;
}
__device__ __forceinline__ float siluf(float v) { return v * __builtin_amdgcn_rcpf(1.f + __expf(-v)); }
__device__ __forceinline__ float sigmf(float v) { return __builtin_amdgcn_rcpf(1.f + __expf(-v)); }
__device__ __forceinline__ int crow(int r, int hi) { return (r & 3) + 8 * (r >> 2) + 4 * hi; }
__device__ __forceinline__ s16x4 vtr(const LAS unsigned char* p) { return __builtin_bit_cast(s16x4, __builtin_amdgcn_ds_read_tr16_b64_v4i16((LAS v4i16_t*)p)); }
__device__ __forceinline__ bf16x8 cat8(s16x4 lo, s16x4 hi) { return __builtin_shufflevector(lo, hi, 0, 1, 2, 3, 4, 5, 6, 7); }
__device__ __forceinline__ bf16x8 pack8(const f32x16& x, int s) {
    u32x4 p; p.x = cvtpk(x[8 * s], x[8 * s + 1]); p.y = cvtpk(x[8 * s + 2], x[8 * s + 3]); p.z = cvtpk(x[8 * s + 4], x[8 * s + 5]); p.w = cvtpk(x[8 * s + 6], x[8 * s + 7]);
    return __builtin_bit_cast(bf16x8, p);
}
#ifndef WT_STORES
#define WT_STORES 0
#endif
__device__ __forceinline__ void st16_wt(void* p, u32x4 v) {
#if WT_STORES
    __builtin_nontemporal_store(v, (u32x4*)p);
#else
    *(u32x4*)p = v;
#endif
}
__device__ __forceinline__ void st8_wt(void* p, u32x2 v) {
#if WT_STORES
    __builtin_nontemporal_store(v, (u32x2*)p);
#else
    *(u32x2*)p = v;
#endif
}
#define MFMA32(a, b, c) __builtin_amdgcn_mfma_f32_32x32x16_bf16((a), (b), (c), 0, 0, 0)
#define MFMA16(a, b, c) __builtin_amdgcn_mfma_f32_16x16x32_bf16((a), (b), (c), 0, 0, 0)

__device__ __forceinline__ void transpose_item(const float* src, int ldn, bf16* WT, int K, int n0, int k0, LAS float* scr, int lane) {
    float tv[32];
#pragma unroll
    for (int i = 0; i < 32; ++i) { const int kk = 2 * i + (lane >> 5); tv[i] = src ? src[(size_t)kk * ldn] : 0.f; }
#pragma unroll
    for (int i = 0; i < 32; ++i) { const int kk = 2 * i + (lane >> 5); scr[kk * 33 + (lane & 31)] = tv[i]; }
    asm volatile("s_waitcnt lgkmcnt(0)" ::: "memory");
    const int c = lane & 7;
#pragma unroll
    for (int j = 0; j < 4; ++j) { const int n = (lane >> 3) + 8 * j; const LAS float* s = scr + (8 * c) * 33 + n;
        u32x4 o; o.x = cvtpk(s[0 * 33], s[1 * 33]); o.y = cvtpk(s[2 * 33], s[3 * 33]); o.z = cvtpk(s[4 * 33], s[5 * 33]); o.w = cvtpk(s[6 * 33], s[7 * 33]);
        *(u32x4*)(WT + (size_t)(n0 + n) * K + k0 + 8 * c) = o; }
    asm volatile("s_waitcnt lgkmcnt(0)" ::: "memory");
}

constexpr int TR_IN = 16 * 88, TR_OUT = 16 * 32, TR_13 = 16 * 176, TR_2 = 44 * 32, TR_G = 4 * 8;
constexpr int TR_A = TR_IN + TR_OUT + TR_G;
constexpr int TR_ITEMS = TR_A + TR_13 + TR_2;
__device__ __forceinline__ void transpose_task(const PA& A, int l, int r, LAS float* scr, int lane) {
    unsigned char* ws = A.ws;
    if (r < TR_IN) { const int kb = r / 88, nb = r % 88, n = nb * 32 + (lane & 31);
        int sc; if (n < 768) sc = n; else if (n < 2560) sc = n + 8; else if (n < 2568) sc = 768 + (n - 2560); else sc = -1;
        const float* W = A.in[I_WIN] + (size_t)l * DM * INW;
        transpose_item(sc >= 0 ? W + (size_t)(kb * 64) * INW + sc : nullptr, INW, (bf16*)(ws + OFF_WIN + l * SZ_WIN), DM, nb * 32, kb * 64, scr, lane); return; }
    r -= TR_IN;
    if (r < TR_OUT) { const int kb = r / 32, nb = r % 32; const float* W = A.in[I_WOUT] + (size_t)l * DM * DM;
        transpose_item(W + (size_t)(kb * 64) * DM + nb * 32 + (lane & 31), DM, (bf16*)(ws + OFF_WOUT + l * SZ_WOUT), DM, nb * 32, kb * 64, scr, lane); return; }
    r -= TR_OUT;
    if (r < TR_G) { const int kb = r / 8, nb = r % 8; const float* W = A.in[I_GLUW] + (size_t)l * 256 * 256;
        transpose_item(W + (size_t)(kb * 64) * 256 + nb * 32 + (lane & 31), 256, (bf16*)(ws + OFF_GLU + l * SZ_GLU), 256, nb * 32, kb * 64, scr, lane); return; }
    r -= TR_G;
    if (r < TR_13) { const int kb = r / 176, nb = r % 176, n = nb * 32 + (lane & 31); const int pn = n >> 8, bj = (n >> 7) & 1, i = n & 127;
        const float* W = (bj ? A.in[I_W3] : A.in[I_W1]) + (size_t)l * DM * DFF;
        transpose_item(W + (size_t)(kb * 64) * DFF + pn * 128 + i, DFF, (bf16*)(ws + OFF_W13 + l * SZ_W13), DM, nb * 32, kb * 64, scr, lane); return; }
    r -= TR_13;
    { const int kb = r / 32, nb = r % 32; const float* W = A.in[I_W2] + (size_t)l * DFF * DM;
        transpose_item(W + (size_t)(kb * 64) * DM + nb * 32 + (lane & 31), DM, (bf16*)(ws + OFF_W2 + l * SZ_W2), DFF, nb * 32, kb * 64, scr, lane); }
}
__device__ __forceinline__ void phase_setup1(const PA& A, LAS unsigned char* lds) {
    const int tid = lt_tid(), lane = tid & 63, wave = tid >> 6;
    const int gw = lt_bid() * 8 + wave, NGW = lt_grid() * 8;
    const int gt = lt_bid() * NTHREADS + tid, GT = lt_grid() * NTHREADS;
    unsigned char* ws = A.ws;
    LAS float* scr = (LAS float*)(lds + wave * 16384);
    { const int nl = DEPTH;
      for (int it = gw; it < nl * TR_ITEMS; it += NGW) transpose_task(A, it / TR_ITEMS, it % TR_ITEMS, scr, lane); }
    for (int it = gw; it < DEPTH * 16 * 24; it += NGW) {
        const int l = it / 384, r = it % 384, ks = r / 24, ng = r % 24;
        const float* W = A.in[I_WMOD] + ((size_t)l * DM + ks * 64) * 6144 + ng * 256 + 4 * lane;
        const float cv = A.in[I_C][ks * 64 + lane], cc = A.in[I_CCTX][ks * 64 + lane];
        const float sl = siluf(cv), sc = siluf(cc);
        f32x4 aL = {0, 0, 0, 0}, aC = {0, 0, 0, 0};
#pragma unroll 16
        for (int k = 0; k < 64; ++k) { const f32x4 w = *(const f32x4*)(W + (size_t)k * 6144); const float a = __shfl(sl, k), b = __shfl(sc, k); aL += w * a; aC += w * b; }
        float* mp = (float*)(ws + OFF_MODP) + ((size_t)(l * 16 + ks) * 2) * 6144 + ng * 256 + 4 * lane;
        *(f32x4*)mp = aL; *(f32x4*)(mp + 6144) = aC;
    }
    {
      const f32x4* cs = (const f32x4*)A.in[I_CTX]; f32x4* co = (f32x4*)(ws + OFF_XC);
      for (int i = gt; i < CTX * DM / 4; i += GT) co[i] = cs[i]; }
    for (int i = gt; i < 256 * 8; i += GT) { const int pos = i >> 3, f = i & 7; const float fr = powf(10000.f, -(float)f / 8.f); const float ang = (float)pos * fr;
        float* rp = (float*)(ws + OFF_ROPE) + pos * 16; rp[f] = cosf(ang); rp[8 + f] = sinf(ang); }
    for (int i0 = lt_bid() * NTHREADS; i0 < DEPTH * 2 * 16 * 256; i0 += GT) {
        LAS f32x4* ltab = (LAS f32x4*)lds;
        __syncthreads();
        if (tid < 128) { const int lp = ((i0 >> 8) + (tid >> 6)) * 64 + (tid & 63); const int ldg = lp >> 6;
            const float step = __expf(A.in[I_LSTEP][ldg]);
            const float lr = A.in[I_LRE][lp], li = A.in[I_LIM][lp];
            const float zr = lr * step, zi = li * step, er = expf(zr);
            float sn, cs; sincosf(zi, &sn, &cs);
            const float br = er * cs, bi = er * sn, nr = br - 1.f, ni = bi, den = 1.f / (lr * lr + li * li);
            ltab[tid] = (f32x4){br, bi, (nr * lr + ni * li) * den, (ni * lr - nr * li) * den}; }
        __syncthreads();
        const int i = i0 + tid;
        const int cc = i & 15, c = (i >> 4) & 15, g = (i >> 8) & 15, ld = i >> 12;
        float acc[16];
#pragma unroll
        for (int d = 0; d < 16; ++d) acc[d] = 0.f;
        for (int p = 0; p < 64; ++p) {
            const int lp = (ld * 16 + g) * 64 + p;
            const f32x4 tv = ltab[(tid >> 8) * 64 + p];
            const float br = tv.x, bi = tv.y, qr = tv.z, qi = tv.w;
            const float b_r = A.in[I_BRE][(size_t)lp * 16 + cc], b_i = A.in[I_BIM][(size_t)lp * 16 + cc];
            const float bbr = qr * b_r - qi * b_i, bbi = qr * b_i + qi * b_r;
            const size_t ci = ((size_t)(ld * 16 + g) * 16 + c) * 64 + p;
            const float c_r = A.in[I_CRE][ci], c_i = A.in[I_CIM][ci];
            float wr = c_r * bbr - c_i * bbi, wi = c_r * bbi + c_i * bbr;
#pragma unroll
            for (int d = 0; d < 16; ++d) { acc[d] += wr; const float t = wr * br - wi * bi; wi = wr * bi + wi * br; wr = t; }
        }
        float* kf = (float*)(ws + OFF_KF) + (size_t)(ld * 16 + g) * 4096 + c * 16 + cc;
#pragma unroll
        for (int d = 0; d < 16; ++d) kf[d * 256] = acc[d];
    }
    for (int i = gt; i < DEPTH * 2 * 16 * 64; i += GT) {
        const int g = (i >> 6) & 15, ld = i >> 10;
        const float step = __expf(A.in[I_LSTEP][ld * 16 + g]);
        const float zr = A.in[I_LRE][i] * step * 16.f, zi = A.in[I_LIM][i] * step * 16.f, er = expf(zr);
        float sn, cs; sincosf(zi, &sn, &cs);
        float* lt = (float*)(ws + OFF_LAMT) + (size_t)i * 2; lt[0] = er * cs; lt[1] = er * sn;
    }
    for (int i = gt; i < DEPTH * 2 * 16 * 64 * 17; i += GT) {
        const int e = i % 17, lp = i / 17, g = (lp >> 6) & 15, ld = lp >> 10;
        const float step = __expf(A.in[I_LSTEP][ld * 16 + g]);
        const float lr = A.in[I_LRE][lp], li = A.in[I_LIM][lp];
        const float zr = lr * step, zi = li * step;
        const float pr_ = expf(zr * (float)e); float ps, pc; sincosf(zi * (float)e, &ps, &pc);
        float* pw = (float*)(ws + OFF_POWT) + (size_t)i * 2; pw[0] = pr_ * pc; pw[1] = pr_ * ps;
        if (e == 1) { const float br = pr_ * pc, bi = pr_ * ps, nr = br - 1.f, ni = bi, den = 1.f / (lr * lr + li * li);
            float* qf = (float*)(ws + OFF_QF) + (size_t)lp * 2; qf[0] = (nr * lr + ni * li) * den; qf[1] = (ni * lr - nr * li) * den; }
    }
}

__device__ __forceinline__ void phase_setup2(const PA& A) {
    const int tid = lt_tid();
    const int gt = lt_bid() * NTHREADS + tid, GT = lt_grid() * NTHREADS;
    unsigned char* ws = A.ws;
    for (int i = gt; i < DEPTH * 2 * 6144; i += GT) { const int n = i % 6144, v = (i / 6144) & 1, l = i / 12288;
        float s = A.in[I_BMOD][l * 6144 + n]; const float* mp = (const float*)(ws + OFF_MODP) + ((size_t)(l * 16) * 2 + v) * 6144 + n;
#pragma unroll
        for (int ks = 0; ks < 16; ++ks) s += mp[(size_t)ks * 2 * 6144];
        ((float*)(ws + OFF_MOD))[i] = s; }
    for (int i = gt; i < DEPTH * 16 * 256 * 256; i += GT) {
        const int k = i & 255, n = (i >> 8) & 255, g = (i >> 16) & 15, l = i >> 20;
        const int dir = n >> 7, ri = (n >> 6) & 1, p = n & 63, s = k >> 4, cc = k & 15;
        const int ld = l * 2 + dir, lp = (ld * 16 + g) * 64 + p;
        const float* qf = (const float*)(ws + OFF_QF) + (size_t)lp * 2; const float qr = qf[0], qi = qf[1];
        const float b_r = A.in[I_BRE][(size_t)lp * 16 + cc], b_i = A.in[I_BIM][(size_t)lp * 16 + cc];
        const float bbr = qr * b_r - qi * b_i, bbi = qr * b_i + qi * b_r;
        const int e = dir == 0 ? 15 - s : s;
        const float* pw = (const float*)(ws + OFF_POWT) + ((size_t)lp * 17 + e) * 2; const float pwr = pw[0], pwi = pw[1];
        const float vr = pwr * bbr - pwi * bbi, vi = pwr * bbi + pwi * bbr;
        ((bf16*)(ws + OFF_BTE))[i] = (bf16)f2bf(ri ? vi : vr);
    }
    for (int i = gt; i < DEPTH * 16 * 256 * 512; i += GT) {
        const int k = i & 511, n = (i >> 9) & 255, g = (i >> 17) & 15, l = i >> 21;
        const int t = n >> 4, c = n & 15;
        float v;
        if (k < 256) { const int s = k >> 4, cc = k & 15; v = 0.f;
            const float* kf0 = (const float*)(ws + OFF_KF) + (size_t)((l * 2 + 0) * 16 + g) * 4096 + c * 16 + cc;
            const float* kf1 = (const float*)(ws + OFF_KF) + (size_t)((l * 2 + 1) * 16 + g) * 4096 + c * 16 + cc;
            if (s <= t) v += kf0[(t - s) * 256];
            if (s >= t) v += kf1[(s - t) * 256];
        } else { const int q = k - 256, dir = q >> 7, ri = (q >> 6) & 1, p = q & 63;
            const int ld = l * 2 + dir, lp = (ld * 16 + g) * 64 + p;
            const int e = dir == 0 ? t + 1 : 16 - t;
            const float* pw = (const float*)(ws + OFF_POWT) + ((size_t)lp * 17 + e) * 2; const float pwr = pw[0], pwi = pw[1];
            const size_t ci = ((size_t)(ld * 16 + g) * 16 + c) * 64 + p;
            const float c_r = A.in[I_CRE][ci], c_i = A.in[I_CIM][ci];
            v = ri ? -(c_r * pwi + c_i * pwr) : (c_r * pwr - c_i * pwi);
        }
        ((bf16*)(ws + OFF_BTY))[i] = (bf16)f2bf(v);
    }
}

__device__ __forceinline__ void phase_modnorm(const PA& A, int layer, int which) {
    const int tid = lt_tid(), lane = tid & 63, wave = tid >> 6;
    const int gw = lt_bid() * 8 + wave, NGW = lt_grid() * 8;
    unsigned char* ws = A.ws;
    const float* g = A.in[which ? I_NORM2 : I_NORM1] + layer * DM;
    const int shi = which ? 3 : 0, sci = which ? 4 : 1;
    bf16* H = (bf16*)(ws + OFF_H);
#pragma unroll 1
    for (int v = 0; v < 2; ++v) {
        const float* mod = (const float*)(ws + OFF_MOD) + (size_t)(layer * 2 + v) * 6144;
        f32x4 a[4], b[4];
#pragma unroll
        for (int j = 0; j < 4; ++j) { const int col = 4 * lane + 256 * j; const f32x4 gv = *(const f32x4*)(g + col), sc = *(const f32x4*)(mod + sci * DM + col);
            a[j] = gv * (sc + 1.0f); b[j] = *(const f32x4*)(mod + shi * DM + col); }
        const int m0 = v ? 0 : CTX, m1 = v ? CTX : MR;
        for (int m = m0 + gw; m < m1; m += 2 * NGW) {
            const int mb = m + NGW < m1 ? m + NGW : m;
            const bool first = (layer == 0 && which == 0);
            const float* xlat = first ? A.in[I_X] : (const float*)A.out;
            const float* xr0 = (m < CTX) ? (const float*)(ws + OFF_XC) + (size_t)m * DM : xlat + (size_t)(m - CTX) * DM;
            const float* xr1 = (mb < CTX) ? (const float*)(ws + OFF_XC) + (size_t)mb * DM : xlat + (size_t)(mb - CTX) * DM;
            f32x4 x[4], y[4]; float s0 = 0.f, s1 = 0.f;
#pragma unroll
            for (int j = 0; j < 4; ++j) { x[j] = *(const f32x4*)(xr0 + 4 * lane + 256 * j); y[j] = *(const f32x4*)(xr1 + 4 * lane + 256 * j); }
#pragma unroll
            for (int j = 0; j < 4; ++j) { s0 += (x[j].x * x[j].x + x[j].y * x[j].y) + (x[j].z * x[j].z + x[j].w * x[j].w); s1 += (y[j].x * y[j].x + y[j].y * y[j].y) + (y[j].z * y[j].z + y[j].w * y[j].w); }
#pragma unroll
            for (int o = 1; o < 64; o <<= 1) { s0 += __shfl_xor(s0, o); s1 += __shfl_xor(s1, o); }
            const float r0 = rsqrtf(s0 * (1.f / DM) + EPS), r1 = rsqrtf(s1 * (1.f / DM) + EPS);
            if (first && m >= CTX) {
#pragma unroll
                for (int j = 0; j < 4; ++j) { *(f32x4*)(A.out + (size_t)(m - CTX) * DM + 4 * lane + 256 * j) = x[j]; if (mb != m) *(f32x4*)(A.out + (size_t)(mb - CTX) * DM + 4 * lane + 256 * j) = y[j]; } }
#pragma unroll
            for (int j = 0; j < 4; ++j) { const f32x4 o = x[j] * r0 * a[j] + b[j]; u32x2 w; w.x = cvtpk(o.x, o.y); w.y = cvtpk(o.z, o.w);
                st8_wt(H + (size_t)m * DM + 4 * lane + 256 * j, w); }
            if (mb != m) {
#pragma unroll
                for (int j = 0; j < 4; ++j) { const f32x4 o = y[j] * r1 * a[j] + b[j]; u32x2 w; w.x = cvtpk(o.x, o.y); w.y = cvtpk(o.z, o.w);
                    st8_wt(H + (size_t)mb * DM + 4 * lane + 256 * j, w); } }
        }
    }
}
#define RLX_AGENT __ATOMIC_RELAXED, __HIP_MEMORY_SCOPE_AGENT
#define XB_TMO      128
#define XB_XCNT(j)  (256  + 64 * (j))
#define XB_XSUB(j)  (1280 + 64 * (j))
#define XB_XGEN(j)  (2304 + 64 * (j))
#define XB_TOP      3328
#define XB_TOPGEN   3392
#define XCD_BAR_WORDS 3456
#define XB_SPIN_CAP (1u << 18)

__device__ __forceinline__ unsigned xb_ld(unsigned* p)              { return __hip_atomic_load(p, __ATOMIC_RELAXED, __HIP_MEMORY_SCOPE_AGENT); }
__device__ __forceinline__ unsigned xb_add(unsigned* p, unsigned v) { return __hip_atomic_fetch_add(p, v, __ATOMIC_RELAXED, __HIP_MEMORY_SCOPE_AGENT); }
__device__ __forceinline__ unsigned xb_xcc_id() { return (unsigned)__builtin_amdgcn_s_getreg((3 << 11) | 20) & 0xFu; }
#define XB_SPIN(cond, bar) do { unsigned _sp = 0; while (cond) { __builtin_amdgcn_s_sleep(1); \
    if ((++_sp & 255u) == 0u) { if (xb_ld(&(bar)[XB_TMO])) break; if (_sp > XB_SPIN_CAP) { atomicAdd(&(bar)[XB_TMO], 1u); break; } } } } while (0)

struct XcdBarrier {
    unsigned* bar; unsigned x;
    volatile LAS unsigned* st;
};

__device__ __forceinline__ XcdBarrier xcd_barrier_post(unsigned* bar, volatile LAS unsigned* st) {
    XcdBarrier b; b.bar = bar; b.x = xb_xcc_id(); b.st = st;
    if (threadIdx.x == 0) (void)xb_add(&bar[XB_XCNT(b.x)], 1u);
    return b;
}
__device__ __forceinline__ void xcd_barrier_complete(unsigned* bar, unsigned x, unsigned& nloc, unsigned& nx) {
    const unsigned G = gridDim.x * gridDim.y * gridDim.z;
    unsigned sum, cnt, mine, sp = 0u;
    for (;;) {
        sum = 0u; cnt = 0u; mine = 0u;
#pragma unroll
        for (unsigned j = 0; j < 16; ++j) { const unsigned c = xb_ld(&bar[XB_XCNT(j)]); sum += c; cnt += (c > 0u) ? 1u : 0u; mine = (j == x) ? c : mine; }
        if (sum == G) break;
        __builtin_amdgcn_s_sleep(1);
        if ((++sp & 255u) == 0u) { if (xb_ld(&bar[XB_TMO])) break; if (sp > XB_SPIN_CAP) { atomicAdd(&bar[XB_TMO], 1u); break; } }
    }
    nloc = mine > 0u ? mine : 1u; nx = cnt > 0u ? cnt : 1u;
}

__device__ __forceinline__ void xcd_barrier(const XcdBarrier& b) {
    asm volatile("s_waitcnt vmcnt(0)" ::: "memory");
    __syncthreads();
    if (threadIdx.x == 0) {
        unsigned* bar = b.bar;
        __builtin_amdgcn_s_waitcnt(0);
        unsigned nloc = b.st[0], nx = b.st[1];
        if (nloc == 0u) { xcd_barrier_complete(bar, b.x, nloc, nx); b.st[0] = nloc; b.st[1] = nx; }
        const unsigned old = xb_add(&bar[XB_XSUB(b.x)], 1u);
        const unsigned gen = old / nloc;
        if (old + 1u == (gen + 1u) * nloc) {
            __builtin_amdgcn_fence(__ATOMIC_RELEASE, "agent");
            asm volatile("s_waitcnt vmcnt(0)" ::: "memory");
            const unsigned og = xb_add(&bar[XB_TOP], 1u);
            const unsigned tg = og / nx;
            if (og + 1u == (tg + 1u) * nx) xb_add(&bar[XB_TOPGEN], 1u);
            else XB_SPIN(xb_ld(&bar[XB_TOPGEN]) == tg, bar);
            __builtin_amdgcn_fence(__ATOMIC_ACQUIRE, "agent");
            xb_add(&bar[XB_XGEN(b.x)], 1u);
            asm volatile("s_waitcnt vmcnt(0)" ::: "memory");
        } else {
            XB_SPIN(xb_ld(&bar[XB_XGEN(b.x)]) == gen, bar);
            __builtin_amdgcn_fence(__ATOMIC_ACQUIRE, "agent");
            asm volatile("s_waitcnt vmcnt(0)" ::: "memory");
        }
    }
    __syncthreads();
}

constexpr float QSCALE = 0.17677669529663687f * 1.4426950408889634f;
struct EpiIn {
    static constexpr bool PERM = true, AFTER_DRAIN = false;
    bf16 *ZB, *XBC, *UB, *QB, *KB, *VB; float* DTB; const float *qn, *kn, *dtbias, *rope;
    __device__ __forceinline__ void operator()(const f32x4 (&acc)[2][2][4][2], const pg8::Unit& u, int wr, int wc, int fr, int fq) const {
        const int pn = u.pn; int row0 = u.pm * 256 + wr * 64 + fr; asm volatile("" : "+v"(row0));
        if (pn <= 3 || pn == 8 || pn == 9) {
            bf16* base; int ld, c0;
            if (pn == 0) { base = ZB; ld = 256; c0 = 0; } else if (pn <= 2) { base = XBC; ld = 512; c0 = (pn - 1) * 256; } else if (pn == 3) { base = UB; ld = 256; c0 = 0; } else { base = VB; ld = 512; c0 = (pn - 8) * 256; }
#pragma unroll
            for (int ai = 0; ai < 2; ++ai)
#pragma unroll
                for (int m = 0; m < 4; ++m) { const int row = row0 + ai * 128 + m * 16;
#pragma unroll
                    for (int bj = 0; bj < 2; ++bj) { f32x4 v0 = acc[ai][bj][m][0], v1 = acc[ai][bj][m][1];
                        if (pn == 0) {
#pragma unroll
                            for (int e = 0; e < 4; ++e) { v0[e] = siluf(v0[e]); v1[e] = siluf(v1[e]); } }
                        u32x4 w; w.x = cvtpk(v0[0], v0[1]); w.y = cvtpk(v0[2], v0[3]); w.z = cvtpk(v1[0], v1[1]); w.w = cvtpk(v1[2], v1[3]);
                        st16_wt(base + (size_t)row * ld + c0 + bj * 128 + wc * 32 + 8 * fq, w); } }
        } else if (pn <= 7) {
            const bool isq = pn <= 5; bf16* base = isq ? QB : KB; const float* nw = isq ? qn : kn; const int c0 = ((pn - 4) & 1) * 256;
            const f32x4 w0 = *(const f32x4*)(nw + 8 * fq), w1 = *(const f32x4*)(nw + 8 * fq + 4);
            const float sgn = (fq & 1) ? 1.f : -1.f;
#pragma unroll
            for (int ai = 0; ai < 2; ++ai)
#pragma unroll
                for (int m = 0; m < 4; ++m) { const int row = row0 + ai * 128 + m * 16; const int t = row - CTX;
                    f32x4 cs0 = {1, 1, 1, 1}, cs1 = {1, 1, 1, 1}, sn0 = {0, 0, 0, 0}, sn1 = {0, 0, 0, 0};
                    if (row >= CTX) { const int pos = (fq < 2) ? (t >> 6) : (t & 63); const float* rp = rope + pos * 16;
                        cs0 = *(const f32x4*)rp; cs1 = *(const f32x4*)(rp + 4); sn0 = *(const f32x4*)(rp + 8); sn1 = *(const f32x4*)(rp + 12); }
#pragma unroll
                    for (int bj = 0; bj < 2; ++bj) { f32x4 v0 = acc[ai][bj][m][0], v1 = acc[ai][bj][m][1];
                        float ss = (v0[0] * v0[0] + v0[1] * v0[1]) + (v0[2] * v0[2] + v0[3] * v0[3]) + (v1[0] * v1[0] + v1[1] * v1[1]) + (v1[2] * v1[2] + v1[3] * v1[3]);
                        ss += __shfl_xor(ss, 16); ss += __shfl_xor(ss, 32);
                        const float r = rsqrtf(ss * (1.f / 32.f) + EPS);
                        v0 = v0 * r * w0; v1 = v1 * r * w1;
                        f32x4 p0, p1;
#pragma unroll
                        for (int e = 0; e < 4; ++e) { p0[e] = __shfl_xor(v0[e], 16); p1[e] = __shfl_xor(v1[e], 16); }
                        v0 = v0 * cs0 + p0 * sn0 * sgn; v1 = v1 * cs1 + p1 * sn1 * sgn;
                        if (isq) { v0 = v0 * QSCALE; v1 = v1 * QSCALE; }
                        u32x4 w; w.x = cvtpk(v0[0], v0[1]); w.y = cvtpk(v0[2], v0[3]); w.z = cvtpk(v1[0], v1[1]); w.w = cvtpk(v1[2], v1[3]);
                        st16_wt(base + (size_t)row * 512 + c0 + bj * 128 + wc * 32 + 8 * fq, w); } }
        } else {
            if (wc == 0 && fq == 0) {
                const f32x4 b0 = *(const f32x4*)dtbias, b1 = *(const f32x4*)(dtbias + 4);
#pragma unroll
                for (int ai = 0; ai < 2; ++ai)
#pragma unroll
                    for (int m = 0; m < 4; ++m) { const int row = row0 + ai * 128 + m * 16; f32x4 v0 = acc[ai][0][m][0] + b0, v1 = acc[ai][0][m][1] + b1;
#pragma unroll
                        for (int e = 0; e < 4; ++e) { v0[e] = v0[e] > 20.f ? v0[e] : __logf(1.f + __expf(v0[e])); v1[e] = v1[e] > 20.f ? v1[e] : __logf(1.f + __expf(v1[e])); }
                        *(f32x4*)(DTB + (size_t)row * 8) = v0; *(f32x4*)(DTB + (size_t)row * 8 + 4) = v1; }
            }
        }
    }
};
struct SplitOrder {
    pg8::StaticOrder S0; int G, c, nkt_full, nsplit, with_ctx, r0;
    __device__ __forceinline__ void init(int G_, int c_, int nkt_, int nsplit_, bool ctx_) { S0.init(SEQ, DM, G_, c_); S0.nkt = nkt_; G = G_; c = c_; nkt_full = nkt_; nsplit = nsplit_; with_ctx = ctx_ ? 1 : 0; r0 = (256 + G_ - 1) / G_; }
    __device__ __forceinline__ bool next(int i, pg8::Unit& u) const {
        const bool own_ctx = with_ctx && G >= 256 && c < 4 * nsplit;
        if (own_ctx) { if (i == 0) { u.pm = 0; u.pn = c & 3; u.k0 = (c >> 2) * 256; u.nkt = 4; return true; } i -= 1; }
        if (i < r0) { if (S0.next(i, u)) { u.pm += 1; return true; } }
        if (!with_ctx || G >= 256) return false;
        const int j = (i - r0) * G + c;
        if (i < r0 || j >= 4 * nsplit) return false;
        u.pm = 0; u.pn = j & 3; u.k0 = (j >> 2) * 256; u.nkt = 4; return true;
    }
    __device__ __forceinline__ void a_ready(const pg8::Unit&) const {}
    __device__ __forceinline__ void done(const pg8::Unit&) const {}
};
struct EpiRes {
    static constexpr bool PERM = true, AFTER_DRAIN = false;
    float* outx; float* xc; const float* gate_l; const float* gate_c; float gscale;
    __device__ __forceinline__ void operator()(const f32x4 (&acc)[2][2][4][2], const pg8::Unit& u, int wr, int wc, int fr, int fq) const {
        int fq2 = fq; asm volatile("" : "+v"(fq2));
        int row0 = u.pm * 256 + wr * 64 + fr; asm volatile("" : "+v"(row0));
#pragma unroll
        for (int ai = 0; ai < 2; ++ai)
#pragma unroll
            for (int m = 0; m < 4; ++m) { const int row = row0 + ai * 128 + m * 16;
                float* xr = row < CTX ? xc + (size_t)row * DM : outx + (size_t)(row - CTX) * DM; const float* gt = row < CTX ? gate_c : gate_l;
#pragma unroll
                for (int bj = 0; bj < 2; ++bj) { const int col = u.pn * 256 + bj * 128 + wc * 32 + 8 * fq2;
#pragma unroll
                    for (int n = 0; n < 2; ++n) { const f32x4 g = *(const f32x4*)(gt + col + 4 * n) * gscale;
                        if (u.pm == 0) { const f32x4 v = g * acc[ai][bj][m][n];
#pragma unroll
                            for (int e = 0; e < 4; ++e) (void)__hip_atomic_fetch_add(xr + col + 4 * n + e, v[e], __ATOMIC_RELAXED, __HIP_MEMORY_SCOPE_AGENT); }
                        else { f32x4 x = *(const f32x4*)(xr + col + 4 * n); x += g * acc[ai][bj][m][n]; st16_wt(xr + col + 4 * n, __builtin_bit_cast(u32x4, x)); } } }
                asm volatile("" ::: "memory"); }
    }
};
struct EpiFfn {
    static constexpr bool PERM = true, AFTER_DRAIN = false;
    bf16* FFU;
    __device__ __forceinline__ void operator()(const f32x4 (&acc)[2][2][4][2], const pg8::Unit& u, int wr, int wc, int fr, int fq) const {
        int row0 = u.pm * 256 + wr * 64 + fr; asm volatile("" : "+v"(row0));
#pragma unroll
        for (int ai = 0; ai < 2; ++ai)
#pragma unroll
            for (int m = 0; m < 4; ++m) { const int row = row0 + ai * 128 + m * 16;
                f32x4 v0 = acc[ai][0][m][0], v1 = acc[ai][0][m][1]; const f32x4 g0 = acc[ai][1][m][0], g1 = acc[ai][1][m][1];
#pragma unroll
                for (int e = 0; e < 4; ++e) { v0[e] = siluf(v0[e]) * g0[e]; v1[e] = siluf(v1[e]) * g1[e]; }
                u32x4 w; w.x = cvtpk(v0[0], v0[1]); w.y = cvtpk(v0[2], v0[3]); w.z = cvtpk(v1[0], v1[1]); w.w = cvtpk(v1[2], v1[3]);
                st16_wt(FFU + (size_t)row * DFF + u.pn * 128 + wc * 32 + 8 * fq, w); }
    }
};
struct EpiGlu {
    static constexpr bool PERM = true, AFTER_DRAIN = false;
    const bf16* YG; bf16* MIX; const float* gb;
    __device__ __forceinline__ void operator()(const f32x4 (&acc)[2][2][4][2], const pg8::Unit& u, int wr, int wc, int fr, int fq) const {
        int fq2 = fq; asm volatile("" : "+v"(fq2));
        int row0 = u.pm * 256 + wr * 64 + fr; asm volatile("" : "+v"(row0));
#pragma unroll
        for (int ai = 0; ai < 2; ++ai)
#pragma unroll
            for (int m = 0; m < 4; ++m) { const int row = row0 + ai * 128 + m * 16;
#pragma unroll
                for (int bj = 0; bj < 2; ++bj) { const int col = bj * 128 + wc * 32 + 8 * fq2;
                    const u32x4 yv = *(const u32x4*)(YG + (size_t)row * 256 + col);
                    const f32x4 b0 = *(const f32x4*)(gb + col), b1 = *(const f32x4*)(gb + col + 4);
                    f32x4 v0 = acc[ai][bj][m][0] + b0, v1 = acc[ai][bj][m][1] + b1;
                    float y[8]; y[0] = bf2f(yv.x & 0xffff); y[1] = bf2f(yv.x >> 16); y[2] = bf2f(yv.y & 0xffff); y[3] = bf2f(yv.y >> 16);
                    y[4] = bf2f(yv.z & 0xffff); y[5] = bf2f(yv.z >> 16); y[6] = bf2f(yv.w & 0xffff); y[7] = bf2f(yv.w >> 16);
#pragma unroll
                    for (int e = 0; e < 4; ++e) { v0[e] = y[e] * sigmf(v0[e]); v1[e] = y[4 + e] * sigmf(v1[e]); }
                    u32x4 w; w.x = cvtpk(v0[0], v0[1]); w.y = cvtpk(v0[2], v0[3]); w.z = cvtpk(v1[0], v1[1]); w.w = cvtpk(v1[2], v1[3]);
                    *(u32x4*)(MIX + (size_t)row * DM + 256 + col) = w; }
                asm volatile("" ::: "memory"); }
    }
};

constexpr int AKS = 144;
constexpr int ASTB = 128 * AKS;
#ifndef VKS_BYTES
#define VKS_BYTES 192
#endif
constexpr int VKS = VKS_BYTES;
constexpr int VSTB = 128 * VKS;
constexpr int VBASE = 3 * ASTB;
static_assert(VBASE + 3 * VSTB <= 131072, "attention LDS");
#ifndef EXP_POLY_MASK
#define EXP_POLY_MASK 0
#endif
__device__ __forceinline__ float exp2_poly(float x) {
    const float M = 12582912.f;
    const float t = x + M;
    const float f = x - (t - M);
    const float p = __builtin_fmaf(__builtin_fmaf(__builtin_fmaf(0.0551716685f, f, 0.2426111251f), f, 0.6932609677f), f, 0.9999280572f);
    return __builtin_bit_cast(float, __builtin_bit_cast(int, p) + (__builtin_bit_cast(int, t) << 23));
}
__device__ __forceinline__ void attn_qk(f32x16 (&st)[2], const LAS unsigned char* Kb, int half, const bf16x8 (&qf)[2][2], int r, int hi) {
#pragma unroll
    for (int c = 0; c < 2; ++c) {
        const LAS unsigned char* kp = Kb + (32 * half + r) * AKS + c * 64 + hi * 16;
        const bf16x8 a0 = *(const LAS bf16x8*)kp, a1 = *(const LAS bf16x8*)(kp + 32);
        f32x16 z;
#pragma unroll
        for (int i = 0; i < 16; ++i) z[i] = 0.f;
        z = MFMA32(a0, qf[c][0], z); st[c] = MFMA32(a1, qf[c][1], z);
    }
}
#ifndef ATT_NOPF
#define ATT_NOPF 0
#endif
#ifndef ATT_PACKORDER
#define ATT_PACKORDER 0
#endif
#ifndef ATT_VSUM
#define ATT_VSUM 0
#endif
#ifndef ATT_SB
#define ATT_SB 0
#endif
#if ATT_SB
#define ATT_SBAR() __builtin_amdgcn_sched_barrier(0)
#else
#define ATT_SBAR() do {} while (0)
#endif
__device__ __forceinline__ void attn_half(f32x16 (&cur)[2], f32x16 (&nxt)[2], const LAS unsigned char* Knext, bool has_next, const LAS unsigned char* Vh, f32x16 (&O)[2][2], f32x4 (&ls4)[2], const bf16x8 aones,
                                          const bf16x8 (&qf)[2][2], int r, int hi, int vrd) {
#ifndef ATT_IGLP
#define ATT_IGLP 3
#endif
#if ATT_IGLP >= 0
    __builtin_amdgcn_iglp_opt(ATT_IGLP);
#endif
    bf16x8 kf[2][2], vf[2][2];
#if ATT_NOPF
    const LAS unsigned char* kp = Knext + r * AKS + hi * 16;
#else
    const LAS unsigned char* kp = Knext + r * AKS + hi * 16;
#endif
#pragma unroll
    for (int c = 0; c < 2; ++c) { kf[c][0] = *(const LAS bf16x8*)(kp + c * 64); kf[c][1] = *(const LAS bf16x8*)(kp + c * 64 + 32); }
#pragma unroll
    for (int sp = 0; sp < 2; ++sp)
#pragma unroll
        for (int vt = 0; vt < 2; ++vt) { const LAS unsigned char* vp = Vh + (16 * sp) * VKS + (32 * vt) * 2 + vrd; vf[sp][vt] = cat8(vtr(vp), vtr(vp + 8 * VKS)); }
#pragma unroll
    for (int c = 0; c < 2; ++c) { f32x16 z;
#pragma unroll
        for (int i = 0; i < 16; ++i) z[i] = 0.f;
        z = MFMA32(kf[c][0], qf[c][0], z);
#if ATT_NOPF
        cur[c] = MFMA32(kf[c][1], qf[c][1], z); }
#else
        nxt[c] = MFMA32(kf[c][1], qf[c][1], z); }
#endif
#if ATT_PACKORDER
#pragma unroll
    for (int sp = 0; sp < 2; ++sp)
#pragma unroll
        for (int c = 0; c < 2; ++c) {
#pragma unroll
            for (int i = 8 * sp; i < 8 * sp + 8; ++i) cur[c][i] = __builtin_amdgcn_exp2f(cur[c][i]);
            const bf16x8 pk = pack8(cur[c], sp);
            ls4[c] = MFMA16(aones, pk, ls4[c]);
            O[c][0] = MFMA32(vf[sp][0], pk, O[c][0]);
            O[c][1] = MFMA32(vf[sp][1], pk, O[c][1]);
        }
#else
    bf16x8 pb[2][2];
#ifdef PROBE_EXP2X
    float zprobe = 0.f; asm volatile("" : "+v"(zprobe));
#endif
#pragma unroll
    for (int c = 0; c < 2; ++c) {
#pragma unroll
        for (int i = 0; i < 16; ++i) {
#ifdef PROBE_EXP2X
            const float e1 = __builtin_amdgcn_exp2f(cur[c][i]), e2 = __builtin_amdgcn_exp2f(cur[c][i] + zprobe); cur[c][i] = 0.5f * (e1 + e2);
#else
            cur[c][i] = ((EXP_POLY_MASK >> i) & 1) ? exp2_poly(cur[c][i]) : __builtin_amdgcn_exp2f(cur[c][i]);
#endif
        }
    }
#pragma unroll
    for (int c = 0; c < 2; ++c) {
        pb[c][0] = pack8(cur[c], 0); pb[c][1] = pack8(cur[c], 1);
#if ATT_VSUM
        { float s0 = 0.f, s1 = 0.f;
#pragma unroll
          for (int i = 0; i < 16; i += 2) { s0 += cur[c][i]; s1 += cur[c][i + 1]; }
          ls4[c][0] += s0 + s1; }
#else
        ls4[c] = MFMA16(aones, pb[c][0], ls4[c]); ls4[c] = MFMA16(aones, pb[c][1], ls4[c]);
#endif
    }
#if ATT_VSUM
    asm volatile("" : "+v"(ls4[0][0]), "+v"(ls4[1][0]));
#endif
#pragma unroll
    for (int sp = 0; sp < 2; ++sp)
#pragma unroll
        for (int vt = 0; vt < 2; ++vt) {
            O[0][vt] = MFMA32(vf[sp][vt], pb[0][sp], O[0][vt]);
            O[1][vt] = MFMA32(vf[sp][vt], pb[1][sp], O[1][vt]);
        }
#endif
#ifndef ATT_SGB
#define ATT_SGB 0
#endif
#if ATT_SGB == 2
    __builtin_amdgcn_sched_group_barrier(0x100, 4, 0);
#pragma unroll
    for (int k = 0; k < 16; ++k) { __builtin_amdgcn_sched_group_barrier(0x008, 1, 0); __builtin_amdgcn_sched_group_barrier(0x400, 2, 0); __builtin_amdgcn_sched_group_barrier(0x100, 1, 0); __builtin_amdgcn_sched_group_barrier(0x002, 1, 0); }
#elif ATT_SGB
    __builtin_amdgcn_sched_group_barrier(0x100, 12, 0);
#pragma unroll
    for (int k = 0; k < 4; ++k) { __builtin_amdgcn_sched_group_barrier(0x008, 1, 0); __builtin_amdgcn_sched_group_barrier(0x002, 8, 0); }
#pragma unroll
    for (int k = 0; k < 12; ++k) { __builtin_amdgcn_sched_group_barrier(0x008, 1, 0); __builtin_amdgcn_sched_group_barrier(0x002, 2, 0); }
#endif
}
__device__ __forceinline__ void phase_attn(const PA& A, int layer, LAS unsigned char* lds) {
    const int tid = lt_tid(), lane = tid & 63, r = lane & 31, hi = lane >> 5;
    const int wid = __builtin_amdgcn_readfirstlane(tid >> 6);
    const int i16 = lane & 15, q4 = i16 >> 2, p4 = i16 & 3, blk = (lane >> 4) & 1;
    unsigned char* ws = A.ws;
    const bf16* QB = (const bf16*)(ws + OFF_QB); const bf16* KB = (const bf16*)(ws + OFF_KB); const bf16* VB = (const bf16*)(ws + OFF_VB);
    bf16* MIX = (bf16*)(ws + OFF_MIX);
    const float lam_init = 0.8f - 0.6f * __expf(-0.3f * (float)layer);
    float lamv;
    { const float* lv = A.in[I_DALAM] + layer * 128; float a = (lane < 32) ? lv[lane] * lv[32 + lane] : 0.f, b = (lane < 32) ? lv[64 + lane] * lv[96 + lane] : 0.f;
      a = wave_sum(a); b = wave_sum(b); lamv = __expf(a) - __expf(b) + lam_init; }
    const float post = 1.f - lam_init;
    const float* subn = A.in[I_SUBN] + layer * 64;
    const int skey = tid >> 3, spc = tid & 7;
    const unsigned soff = skey * AKS + spc * 16;
    const unsigned svoff = skey * VKS + spc * 16;
    const int vrd = (4 * hi + q4) * VKS + (16 * blk) * 2 + 8 * p4;
    bf16x8 aones; { const short one = ((((lane & 15) >> 3) & 1) == ((lane >> 4) & 1)) ? (short)0x3F80 : (short)0;
#pragma unroll
        for (int j = 0; j < 8; ++j) aones[j] = one; }
    const int abid = lt_bid(), agrid = lt_grid();
    const int n_lat = (512 - abid + agrid - 1) / agrid;
    const int n_units = n_lat + ((abid >= 128 && abid < 136) ? 1 : 0);
#ifndef ATT_PRIO
#define ATT_PRIO 0
#endif
#if ATT_PRIO
    if (wid >= 4) __builtin_amdgcn_s_setprio(2);
#endif
    for (int ui = 0; ui < n_units; ++ui) {
        const int u = ui < n_lat ? abid + ui * agrid : 512 + (abid - 128);
        const int h = u & 7, qb = u >> 3;
        const int qrow0 = qb < 64 ? CTX + qb * 256 : 0; const int nst = qb < 64 ? MR / 128 : CTX / 128;
        const bf16* qp = QB + (size_t)(qrow0 + wid * 32 + r) * 512 + h * 64 + hi * 8;
        bf16x8 qf[2][2];
#pragma unroll
        for (int c = 0; c < 2; ++c)
#pragma unroll
            for (int s = 0; s < 2; ++s) qf[c][s] = *(const bf16x8*)(qp + c * 32 + s * 16);
        const bf16* kg = KB + (size_t)skey * 512 + h * 64 + spc * 8; const bf16* vg = VB + (size_t)skey * 512 + h * 64 + spc * 8;
        u32x4 kr0 = *(const u32x4*)kg, kr1 = *(const u32x4*)(kg + 64 * 512), vr0 = *(const u32x4*)vg, vr1 = *(const u32x4*)(vg + 64 * 512);
        __syncthreads();
        *(LAS u32x4*)(lds + soff) = kr0; *(LAS u32x4*)(lds + 64 * AKS + soff) = kr1;
        *(LAS u32x4*)(lds + VBASE + svoff) = vr0; *(LAS u32x4*)(lds + VBASE + 64 * VKS + svoff) = vr1;
        { kr0 = *(const u32x4*)(kg + (size_t)128 * 512); kr1 = *(const u32x4*)(kg + (size_t)192 * 512); vr0 = *(const u32x4*)(vg + (size_t)128 * 512); vr1 = *(const u32x4*)(vg + (size_t)192 * 512); }
        __syncthreads();
        f32x16 O[2][2];
#pragma unroll
        for (int c = 0; c < 2; ++c)
#pragma unroll
            for (int vt = 0; vt < 2; ++vt)
#pragma unroll
                for (int i = 0; i < 16; ++i) O[c][vt][i] = 0.f;
        f32x4 ls4[2] = {{0.f, 0.f, 0.f, 0.f}, {0.f, 0.f, 0.f, 0.f}};
        f32x16 sa[2], sb[2];
        attn_qk(sa, lds, 0, qf, r, hi);
        int bcur = 0;
#pragma unroll 2
        for (int s = 0; s < nst; ++s) {
            const int bnext = bcur == 2 ? 0 : bcur + 1;
            const LAS unsigned char* Kc = lds + bcur * ASTB; const LAS unsigned char* Vc = lds + VBASE + bcur * VSTB;
            const LAS unsigned char* Kn = lds + bnext * ASTB;
            *(LAS u32x4*)(lds + bnext * ASTB + soff) = kr0; *(LAS u32x4*)(lds + bnext * ASTB + 64 * AKS + soff) = kr1;
            *(LAS u32x4*)(lds + VBASE + bnext * VSTB + svoff) = vr0; *(LAS u32x4*)(lds + VBASE + bnext * VSTB + 64 * VKS + svoff) = vr1;
            { const int s2 = s + 2 < nst ? s + 2 : nst - 1; const size_t go = (size_t)s2 * 128 * 512; kr0 = *(const u32x4*)(kg + go); kr1 = *(const u32x4*)(kg + go + 64 * 512); vr0 = *(const u32x4*)(vg + go); vr1 = *(const u32x4*)(vg + go + 64 * 512); }
            ATT_SBAR();
            attn_half(sa, sb, Kc + 32 * AKS, true, Vc, O, ls4, aones, qf, r, hi, vrd);
            ATT_SBAR();
            attn_half(sb, sa, Kc + 64 * AKS, true, Vc + 32 * VKS, O, ls4, aones, qf, r, hi, vrd);
            ATT_SBAR();
            attn_half(sa, sb, Kc + 96 * AKS, true, Vc + 64 * VKS, O, ls4, aones, qf, r, hi, vrd);
            ATT_SBAR();
            asm volatile("s_waitcnt lgkmcnt(0)\n\ts_barrier" ::: "memory");
            attn_half(sb, sa, Kn, true, Vc + 96 * VKS, O, ls4, aones, qf, r, hi, vrd);
            ATT_SBAR();
            bcur = bnext;
        }
#if ATT_VSUM
        const float l0 = ls4[0][0] + __shfl_xor(ls4[0][0], 32), l1 = ls4[1][0] + __shfl_xor(ls4[1][0], 32);
#else
        const int lsrc = r < 16 ? r : r + 16;
        const float l0 = __shfl(ls4[0][0], lsrc), l1 = __shfl(ls4[1][0], lsrc);
#endif
        const float inv0 = 1.f / l0, inv1 = lamv / l1;
        float ss = 0.f;
#pragma unroll
        for (int vt = 0; vt < 2; ++vt)
#pragma unroll
            for (int i = 0; i < 16; ++i) { const float o = O[0][vt][i] * inv0 - O[1][vt][i] * inv1; O[0][vt][i] = o; ss += o * o; }
        ss += __shfl_xor(ss, 32);
        const float rn = rsqrtf(ss * (1.f / 64.f) + EPS) * post;
        const int row = qrow0 + wid * 32 + r;
#pragma unroll
        for (int vt = 0; vt < 2; ++vt)
#pragma unroll
            for (int g4 = 0; g4 < 4; ++g4) { const int v0 = 32 * vt + 8 * g4 + 4 * hi; const f32x4 sw = *(const f32x4*)(subn + v0);
                u32x2 w; w.x = cvtpk(O[0][vt][4 * g4] * rn * sw[0], O[0][vt][4 * g4 + 1] * rn * sw[1]); w.y = cvtpk(O[0][vt][4 * g4 + 2] * rn * sw[2], O[0][vt][4 * g4 + 3] * rn * sw[3]);
                *(u32x2*)(MIX + (size_t)row * DM + 512 + h * 64 + v0) = w; }
    }
#if ATT_PRIO
    __builtin_amdgcn_s_setprio(0);
#endif
}

constexpr int XST = 528, BST = 272;
constexpr int L_X0 = 0, L_X1 = 64 * XST, L_B = 2 * 64 * XST, L_C = L_B + 64 * BST, L_SC = L_C + 64 * BST;
constexpr int L_DT = L_SC + 2048, L_WT = L_DT + 2048, L_SSQ = L_WT + 2048, L_SSD_END = L_SSQ + 1024;
static_assert(L_SSD_END <= 131072, "ssd lds");

__device__ __forceinline__ float ssd_scan_dt(const PA& A, int layer, int ch, LAS unsigned char* lds, int w, int lane) {
    const float* DTB = (const float*)(A.ws + OFF_DTB);
    const float dt = DTB[(size_t)(ch * 64 + lane) * 8 + w];
    const float a = -__expf(A.in[I_ALOG][layer * 8 + w]);
    const float v = dt * a; float x = v;
#pragma unroll
    for (int o = 1; o < 64; o <<= 1) { const float y = __shfl_up(x, o); if (lane >= o) x += y; }
    const float total = __shfl(x, 63);
    LAS float* SC = (LAS float*)(lds + L_SC); LAS float* DT = (LAS float*)(lds + L_DT); LAS float* WT = (LAS float*)(lds + L_WT);
    DT[w * 64 + lane] = dt;
    if (w < 4) { SC[w * 64 + lane] = x; WT[w * 64 + lane] = dt * __expf(total - x); }
    else { SC[w * 64 + lane] = total - x + v; WT[w * 64 + lane] = dt * __expf(x - v); }
    return __expf(total);
}

template <int MODE> __device__ __forceinline__ void ssd_conv(const PA& A, int layer, int ch, LAS unsigned char* lds, int tid) {
    const bf16* XBC = (const bf16*)(A.ws + OFF_XBC);
    const int c = tid;
    bf16* XACT = (bf16*)(A.ws + OFF_XACT);
    const float* cw = A.in[I_CONVW] + layer * 3 * 512; const float w0 = cw[c], w1 = cw[512 + c], w2 = cw[1024 + c], b = A.in[I_CONVB][layer * 512 + c];
    const int row0 = ch * 64; const int seq0 = ch < 4 ? 0 : CTX, seq1 = ch < 4 ? CTX : MR;
    const LAS float* WT = (const LAS float*)(lds + L_WT);
    const int h = c >> 6;
#define CONV_LOAD(dst, tb_) do { _Pragma("unroll") for (int t_ = 0; t_ < 18; ++t_) { const int row_ = row0 + (tb_) - 1 + t_; const int rc_ = row_ < seq0 ? seq0 : (row_ >= seq1 ? seq1 - 1 : row_); dst[t_] = XBC[(size_t)rc_ * 512 + c]; } } while (0)
#define CONV_COMPUTE(src, tb_) do { float xm_ = (row0 + (tb_) > seq0) ? bf2f(src[0]) : 0.f; float x0_ = bf2f(src[1]); \
        _Pragma("unroll") for (int tt_ = 0; tt_ < 16; ++tt_) { const int t = (tb_) + tt_; \
            const float xp_ = (row0 + t + 1 < seq1) ? bf2f(src[tt_ + 2]) : 0.f; \
            const float v_ = w0 * xm_ + w1 * x0_ + w2 * xp_ + b; const float s = siluf(v_); \
            if (MODE == 0) XACT[(size_t)(row0 + t) * 512 + c] = (bf16)f2bf(s); \
            if (c < 256) { \
                if (MODE == 0) { *(LAS bf16*)(lds + L_X0 + t * XST + c * 2) = (bf16)f2bf(s * WT[h * 64 + t]); *(LAS bf16*)(lds + L_X1 + t * XST + c * 2) = (bf16)f2bf(s * WT[(4 + h) * 64 + t]); } \
                else *(LAS bf16*)(lds + L_X0 + t * XST + c * 2) = (bf16)f2bf(s); \
            } else if (c < 384) *(LAS bf16*)(lds + L_B + t * BST + (c - 256) * 2) = (bf16)f2bf(s); \
            else if (MODE == 1) *(LAS bf16*)(lds + L_C + t * BST + (c - 384) * 2) = (bf16)f2bf(s); \
            xm_ = x0_; x0_ = xp_; } } while (0)
    unsigned short xa[18], xb[18];
    CONV_LOAD(xa, 0);
#pragma unroll 1
    for (int tb = 0; tb < 64; tb += 32) {
        CONV_LOAD(xb, tb + 16);
        CONV_COMPUTE(xa, tb);
        { const int tn = tb + 32 < 64 ? tb + 32 : 0; CONV_LOAD(xa, tn); }
        CONV_COMPUTE(xb, tb + 16);
    }
#undef CONV_LOAD
#undef CONV_COMPUTE
}

__device__ __forceinline__ void ssd_states_item(const PA& A, int layer, int ch, LAS unsigned char* lds) {
    const int tid = lt_tid(), lane = tid & 63, r = lane & 31, hi = lane >> 5;
    const int w = __builtin_amdgcn_readfirstlane(tid >> 6);
    const int i16 = lane & 15, q4 = i16 >> 2, p4 = i16 & 3, blk = (lane >> 4) & 1;
    __syncthreads();
    const float dec = ssd_scan_dt(A, layer, ch, lds, w, lane);
    if (lane == 0) ((float*)(A.ws + OFF_SDEC))[ch * 8 + w] = dec;
    __syncthreads();
    ssd_conv<0>(A, layer, ch, lds, tid);
    __syncthreads();
    const int dir = w >> 2, h = w & 3, g = h >> 1;
    const LAS unsigned char* XW = lds + (dir ? L_X1 : L_X0); const LAS unsigned char* BS = lds + L_B;
    f32x16 acc[2][2];
#pragma unroll
    for (int a = 0; a < 2; ++a)
#pragma unroll
        for (int b = 0; b < 2; ++b)
#pragma unroll
            for (int i = 0; i < 16; ++i) acc[a][b][i] = 0.f;
#pragma unroll
    for (int ks = 0; ks < 4; ++ks) {
        bf16x8 af[2], bfr[2];
#pragma unroll
        for (int pt = 0; pt < 2; ++pt) { const LAS unsigned char* p = XW + (16 * ks + 8 * hi + q4) * XST + (h * 64 + 32 * pt + 16 * blk) * 2 + 8 * p4; af[pt] = cat8(vtr(p), vtr(p + 4 * XST)); }
#pragma unroll
        for (int nt = 0; nt < 2; ++nt) { const LAS unsigned char* p = BS + (16 * ks + 8 * hi + q4) * BST + (g * 64 + 32 * nt + 16 * blk) * 2 + 8 * p4; bfr[nt] = cat8(vtr(p), vtr(p + 4 * BST)); }
#pragma unroll
        for (int pt = 0; pt < 2; ++pt)
#pragma unroll
            for (int nt = 0; nt < 2; ++nt) acc[pt][nt] = MFMA32(af[pt], bfr[nt], acc[pt][nt]);
    }
    float* S = (float*)(A.ws + OFF_SST) + (size_t)ch * 32768 + dir * 16384 + h * 4096;
#pragma unroll
    for (int pt = 0; pt < 2; ++pt)
#pragma unroll
        for (int nt = 0; nt < 2; ++nt)
#pragma unroll
            for (int i = 0; i < 16; ++i) S[(32 * pt + crow(i, hi)) * 64 + 32 * nt + r] = acc[pt][nt][i];
}

__device__ __forceinline__ void ssd_out_item(const PA& A, int layer, int ch, LAS unsigned char* lds) {
    const int tid = lt_tid(), lane = tid & 63, r = lane & 31, hi = lane >> 5;
    const int w = __builtin_amdgcn_readfirstlane(tid >> 6);
    const int i16 = lane & 15, q4 = i16 >> 2, p4 = i16 & 3, blk = (lane >> 4) & 1;
    const int h = w >> 1, lt = w & 1, g = h >> 1;
    const bf16* SE = (const bf16*)(A.ws + OFF_SENT) + (size_t)ch * 32768 + h * 4096;
    bf16x8 sef[4][2], seb[4][2];
#pragma unroll
    for (int ks = 0; ks < 4; ++ks)
#pragma unroll
        for (int pt = 0; pt < 2; ++pt) { const bf16* sp = SE + (32 * pt + r) * 64 + 16 * ks + 8 * hi; sef[ks][pt] = *(const bf16x8*)sp; seb[ks][pt] = *(const bf16x8*)(sp + 16384); }
    const bf16* ZBp = (const bf16*)(A.ws + OFF_ZB) + (size_t)(ch * 64 + 32 * lt + r) * 256 + h * 64;
    u32x2 zpre[2][4];
#pragma unroll
    for (int pt = 0; pt < 2; ++pt)
#pragma unroll
        for (int g4 = 0; g4 < 4; ++g4) zpre[pt][g4] = *(const u32x2*)(ZBp + 32 * pt + 8 * g4 + 4 * hi);
    __syncthreads();
    (void)ssd_scan_dt(A, layer, ch, lds, w, lane);
    {
        const bf16* XACT = (const bf16*)(A.ws + OFF_XACT) + (size_t)ch * 64 * 512;
        u32x4 xv[8];
#pragma unroll
        for (int k = 0; k < 8; ++k) xv[k] = *(const u32x4*)(XACT + (size_t)(tid + 512 * k) * 8);
#pragma unroll
        for (int k = 0; k < 8; ++k) { const int idx = tid + 512 * k, rw = idx >> 6, c0 = (idx & 63) * 8;
            LAS unsigned char* dst = c0 < 256 ? lds + L_X0 + rw * XST + c0 * 2 : (c0 < 384 ? lds + L_B + rw * BST + (c0 - 256) * 2 : lds + L_C + rw * BST + (c0 - 384) * 2);
            *(LAS u32x4*)dst = xv[k]; }
    }
    __syncthreads();
    const LAS unsigned char* XS = lds + L_X0; const LAS unsigned char* BS = lds + L_B; const LAS unsigned char* CS = lds + L_C;
    const LAS float* SC = (const LAS float*)(lds + L_SC); const LAS float* DT = (const LAS float*)(lds + L_DT);
    const int l = 32 * lt + r;
    bf16x8 cf[4];
#pragma unroll
    for (int ks = 0; ks < 4; ++ks) cf[ks] = *(const LAS bf16x8*)(CS + l * BST + (g * 64 + 16 * ks + 8 * hi) * 2);
    const float csl = SC[h * 64 + l], rbl = SC[(4 + h) * 64 + l];
    f32x16 yd[2];
#pragma unroll
    for (int pt = 0; pt < 2; ++pt)
#pragma unroll
        for (int i = 0; i < 16; ++i) yd[pt][i] = 0.f;
#pragma unroll
    for (int st = 0; st < 2; ++st) {
        f32x16 gt;
#pragma unroll
        for (int i = 0; i < 16; ++i) gt[i] = 0.f;
#pragma unroll
        for (int ks = 0; ks < 4; ++ks) { const bf16x8 bfr = *(const LAS bf16x8*)(BS + (32 * st + r) * BST + (g * 64 + 16 * ks + 8 * hi) * 2); gt = MFMA32(bfr, cf[ks], gt); }
#pragma unroll
        for (int i = 0; i < 16; ++i) { const int s = 32 * st + crow(i, hi);
            const float ef = (s <= l) ? __expf(csl - SC[h * 64 + s]) * DT[h * 64 + s] : 0.f;
            const float eb = (s >= l) ? __expf(rbl - SC[(4 + h) * 64 + s]) * DT[(4 + h) * 64 + s] : 0.f;
            gt[i] = gt[i] * (ef + eb); }
#pragma unroll
        for (int sp = 0; sp < 2; ++sp) { const bf16x8 mb = pack8(gt, sp);
#pragma unroll
            for (int pt = 0; pt < 2; ++pt) { const LAS unsigned char* p = XS + (32 * st + 16 * sp + 4 * hi + q4) * XST + (h * 64 + 32 * pt + 16 * blk) * 2 + 8 * p4;
                yd[pt] = MFMA32(cat8(vtr(p), vtr(p + 8 * XST)), mb, yd[pt]); } }
    }
    f32x16 yf[2], yb[2];
#pragma unroll
    for (int pt = 0; pt < 2; ++pt)
#pragma unroll
        for (int i = 0; i < 16; ++i) { yf[pt][i] = 0.f; yb[pt][i] = 0.f; }
#pragma unroll
    for (int ks = 0; ks < 4; ++ks)
#pragma unroll
        for (int pt = 0; pt < 2; ++pt) { yf[pt] = MFMA32(sef[ks][pt], cf[ks], yf[pt]); yb[pt] = MFMA32(seb[ks][pt], cf[ks], yb[pt]); }
    const float efl = __expf(csl), ebl = __expf(rbl), dsk = A.in[I_SSDD][layer * 4 + h];
    const int row = ch * 64 + l;
    float ss = 0.f;
#pragma unroll
    for (int pt = 0; pt < 2; ++pt)
#pragma unroll
        for (int g4 = 0; g4 < 4; ++g4) { const int p0 = 32 * pt + 8 * g4 + 4 * hi;
            const u32x2 xv = *(const LAS u32x2*)(XS + l * XST + (h * 64 + p0) * 2); const u32x2 zv = zpre[pt][g4];
            const float xe[4] = {bf2f(xv.x & 0xffff), bf2f(xv.x >> 16), bf2f(xv.y & 0xffff), bf2f(xv.y >> 16)};
            const float ze[4] = {bf2f(zv.x & 0xffff), bf2f(zv.x >> 16), bf2f(zv.y & 0xffff), bf2f(zv.y >> 16)};
#pragma unroll
            for (int e = 0; e < 4; ++e) { const int i = 4 * g4 + e; const float y = (yd[pt][i] + efl * yf[pt][i] + ebl * yb[pt][i] + dsk * xe[e]) * ze[e]; yd[pt][i] = y; ss += y * y; } }
    ss += __shfl_xor(ss, 32);
    LAS float* SSQ = (LAS float*)(lds + L_SSQ);
    if (hi == 0) SSQ[l * 4 + h] = ss;
    __syncthreads();
    const float tot = (SSQ[l * 4] + SSQ[l * 4 + 1]) + (SSQ[l * 4 + 2] + SSQ[l * 4 + 3]);
    const float rn = rsqrtf(tot * (1.f / 256.f) + EPS);
    const float* ng = A.in[I_SSDNORM] + layer * 256 + h * 64;
    bf16* MIX = (bf16*)(A.ws + OFF_MIX) + (size_t)row * DM + h * 64;
#pragma unroll
    for (int pt = 0; pt < 2; ++pt)
#pragma unroll
        for (int g4 = 0; g4 < 4; ++g4) { const int p0 = 32 * pt + 8 * g4 + 4 * hi; const f32x4 gv = *(const f32x4*)(ng + p0);
            u32x2 o; o.x = cvtpk(yd[pt][4 * g4] * rn * gv[0], yd[pt][4 * g4 + 1] * rn * gv[1]); o.y = cvtpk(yd[pt][4 * g4 + 2] * rn * gv[2], yd[pt][4 * g4 + 3] * rn * gv[3]);
            *(u32x2*)(MIX + p0) = o; }
}

__device__ __forceinline__ void s5_e_item(const PA& A, int layer, int ct, int g, int nh, int lane) {
    const int fr = lane & 15, kq = lane >> 4;
    const bf16* UB = (const bf16*)(A.ws + OFF_UB); const bf16* BT = (const bf16*)(A.ws + OFF_BTE + layer * SZ_BTE) + (size_t)g * 65536 + (size_t)nh * 128 * 256;
    f32x4 acc[8];
#pragma unroll
    for (int n = 0; n < 8; ++n) acc[n] = (f32x4){0.f, 0.f, 0.f, 0.f};
    const int chunk = ct * 16 + fr;
    bf16x8 a[8];
#pragma unroll
    for (int kk = 0; kk < 8; ++kk) a[kk] = *(const bf16x8*)(UB + (size_t)(chunk * 16 + 2 * kk + (kq >> 1)) * 256 + g * 16 + 8 * (kq & 1));
#pragma unroll
    for (int kk = 0; kk < 8; ++kk) {
#pragma unroll
        for (int n = 0; n < 8; ++n) { const bf16x8 b = *(const bf16x8*)(BT + (size_t)(16 * n + fr) * 256 + 32 * kk + 8 * kq); acc[n] = MFMA16(a[kk], b, acc[n]); }
    }
    float* E = (float*)(A.ws + OFF_E);
#pragma unroll
    for (int n = 0; n < 8; ++n)
#pragma unroll
        for (int i = 0; i < 4; ++i) E[(size_t)(ct * 16 + 4 * kq + i) * 4096 + g * 256 + nh * 128 + 16 * n + fr] = acc[n][i];
}
__device__ __forceinline__ float gelu_tanh(float y) { const float z = 0.7978845608028654f * (y + 0.044715f * y * y * y); const float t = 1.f - 2.f * __builtin_amdgcn_rcpf(1.f + __expf(2.f * z)); return 0.5f * y * (1.f + t); }
__device__ __forceinline__ void s5_y_item(const PA& A, int layer, int ct, int g, int nh, int lane) {
    const int fr = lane & 15, kq = lane >> 4;
    const bf16* UB = (const bf16*)(A.ws + OFF_UB); const bf16* XSB = (const bf16*)(A.ws + OFF_XS); const bf16* BT = (const bf16*)(A.ws + OFF_BTY + layer * SZ_BTY) + (size_t)g * 131072 + (size_t)nh * 128 * 512;
    f32x4 acc[8];
#pragma unroll
    for (int n = 0; n < 8; ++n) acc[n] = (f32x4){0.f, 0.f, 0.f, 0.f};
    const int chunk = ct * 16 + fr;
    bf16x8 a[16];
#pragma unroll
    for (int kk = 0; kk < 8; ++kk) a[kk] = *(const bf16x8*)(UB + (size_t)(chunk * 16 + 2 * kk + (kq >> 1)) * 256 + g * 16 + 8 * (kq & 1));
#pragma unroll
    for (int kk = 0; kk < 8; ++kk) a[8 + kk] = *(const bf16x8*)(XSB + (size_t)chunk * 4096 + g * 256 + 32 * kk + 8 * kq);
#pragma unroll
    for (int kk = 0; kk < 16; ++kk) {
#pragma unroll
        for (int n = 0; n < 8; ++n) { const bf16x8 b = *(const bf16x8*)(BT + (size_t)(16 * n + fr) * 512 + 32 * kk + 8 * kq); acc[n] = MFMA16(a[kk], b, acc[n]); }
    }
    const float dsk = A.in[I_S5D][layer * 256 + g * 16 + fr];
    bf16* YG = (bf16*)(A.ws + OFF_YG);
#pragma unroll
    for (int n = 0; n < 8; ++n)
#pragma unroll
        for (int i = 0; i < 4; ++i) { const size_t tok = (size_t)(ct * 16 + 4 * kq + i) * 16 + nh * 8 + n; const size_t idx = tok * 256 + g * 16 + fr;
            const float y = acc[n][i] + dsk * bf2f(UB[idx]); YG[idx] = (bf16)f2bf(gelu_tanh(y)); }
}

constexpr int S5E_ST = 528;
__device__ __forceinline__ void s5_e_block(const PA& A, int layer, int item, LAS unsigned char* lds) {
    const int tid = lt_tid(), lane = tid & 63, fr = lane & 15, kq = lane >> 4;
    const int wave = __builtin_amdgcn_readfirstlane(tid >> 6);
    const int combo = item < 240 ? (item >> 2) : 60 + (item - 240) / 3, ng = item < 240 ? 4 : 3, rg = item < 240 ? (item & 3) : (item - 240) % 3;
    const int g = combo & 15, nq = combo >> 4;
    const bf16* UB = (const bf16*)(A.ws + OFF_UB);
    const bf16* BT = (const bf16*)(A.ws + OFF_BTE + layer * SZ_BTE) + (size_t)g * 65536 + (size_t)nq * 64 * 256;
    __syncthreads();
    { u32x4 bv[4];
#pragma unroll
      for (int i = 0; i < 4; ++i) bv[i] = *(const u32x4*)(BT + (size_t)(tid + 512 * i) * 8);
#pragma unroll
      for (int i = 0; i < 4; ++i) { const int idx = tid + 512 * i; *(LAS u32x4*)(lds + (idx >> 5) * S5E_ST + (idx & 31) * 16) = bv[i]; } }
    __syncthreads();
    float* E = (float*)(A.ws + OFF_E);
    const int ct0 = (rg * 65) / ng, ct1 = ((rg + 1) * 65) / ng;
#pragma unroll 1
    for (int ct = ct0 + wave; ct < ct1; ct += 8) {
        const int chunk = ct * 16 + fr;
        bf16x8 a[8];
#pragma unroll
        for (int kk = 0; kk < 8; ++kk) a[kk] = *(const bf16x8*)(UB + (size_t)(chunk * 16 + 2 * kk + (kq >> 1)) * 256 + g * 16 + 8 * (kq & 1));
        f32x4 acc[4];
#pragma unroll
        for (int n = 0; n < 4; ++n) acc[n] = (f32x4){0.f, 0.f, 0.f, 0.f};
#pragma unroll
        for (int kk = 0; kk < 8; ++kk)
#pragma unroll
            for (int n = 0; n < 4; ++n) { const bf16x8 bfr = *(const LAS bf16x8*)(lds + (16 * n + fr) * S5E_ST + (32 * kk + 8 * kq) * 2); acc[n] = MFMA16(a[kk], bfr, acc[n]);
                if (n == 3 && (kk & 1)) asm volatile("" ::: "memory"); }
#pragma unroll
        for (int n = 0; n < 4; ++n)
#pragma unroll
            for (int i = 0; i < 4; ++i) E[(size_t)(ct * 16 + 4 * kq + i) * 4096 + g * 256 + nq * 64 + 16 * n + fr] = acc[n][i];
    }
}

constexpr int S5B_ST = 1040;
__device__ __forceinline__ void s5_y_block(const PA& A, int layer, int item, LAS unsigned char* lds) {
    const int tid = lt_tid(), lane = tid & 63, fr = lane & 15, kq = lane >> 4;
    const int wave = __builtin_amdgcn_readfirstlane(tid >> 6);
    const int combo = item < 240 ? (item >> 2) : 60 + (item - 240) / 3, ng = item < 240 ? 4 : 3, rg = item < 240 ? (item & 3) : (item - 240) % 3;
    const int g = combo & 15, nq = combo >> 4;
    const bf16* UB = (const bf16*)(A.ws + OFF_UB); const bf16* XSB = (const bf16*)(A.ws + OFF_XS);
    const bf16* BT = (const bf16*)(A.ws + OFF_BTY + layer * SZ_BTY) + (size_t)g * 131072 + (size_t)nq * 64 * 512;
    __syncthreads();
    { u32x4 bv[8];
#pragma unroll
      for (int i = 0; i < 8; ++i) bv[i] = *(const u32x4*)(BT + (size_t)(tid + 512 * i) * 8);
#pragma unroll
      for (int i = 0; i < 8; ++i) { const int idx = tid + 512 * i; *(LAS u32x4*)(lds + (idx >> 6) * S5B_ST + (idx & 63) * 16) = bv[i]; } }
    __syncthreads();
    const float dsk = A.in[I_S5D][layer * 256 + g * 16 + fr];
    bf16* YG = (bf16*)(A.ws + OFF_YG);
    const int ct0 = (rg * 65) / ng, ct1 = ((rg + 1) * 65) / ng;
#pragma unroll 1
    for (int ct = ct0 + wave; ct < ct1; ct += 8) {
        const int chunk = ct * 16 + fr;
        bf16x8 a[16];
#pragma unroll
        for (int kk = 0; kk < 8; ++kk) a[kk] = *(const bf16x8*)(UB + (size_t)(chunk * 16 + 2 * kk + (kq >> 1)) * 256 + g * 16 + 8 * (kq & 1));
#pragma unroll
        for (int kk = 0; kk < 8; ++kk) a[8 + kk] = *(const bf16x8*)(XSB + (size_t)chunk * 4096 + g * 256 + 32 * kk + 8 * kq);
        unsigned short uv[4][4];
#pragma unroll
        for (int n = 0; n < 4; ++n)
#pragma unroll
            for (int i = 0; i < 4; ++i) uv[n][i] = UB[((size_t)(ct * 16 + 4 * kq + i) * 16 + nq * 4 + n) * 256 + g * 16 + fr];
        f32x4 acc[4];
#pragma unroll
        for (int n = 0; n < 4; ++n) acc[n] = (f32x4){0.f, 0.f, 0.f, 0.f};
#pragma unroll
        for (int kk = 0; kk < 16; ++kk)
#pragma unroll
            for (int n = 0; n < 4; ++n) { const bf16x8 bfr = *(const LAS bf16x8*)(lds + (16 * n + fr) * S5B_ST + (32 * kk + 8 * kq) * 2); acc[n] = MFMA16(a[kk], bfr, acc[n]);
                if (n == 3 && (kk & 1)) asm volatile("" ::: "memory"); }
#pragma unroll
        for (int n = 0; n < 4; ++n)
#pragma unroll
            for (int i = 0; i < 4; ++i) { const size_t tok = (size_t)(ct * 16 + 4 * kq + i) * 16 + nq * 4 + n; const size_t idx = tok * 256 + g * 16 + fr;
                const float y = acc[n][i] + dsk * bf2f(uv[n][i]); YG[idx] = (bf16)f2bf(gelu_tanh(y)); }
    }
}

__device__ __forceinline__ void phase_scan(const PA& A, int layer, LAS unsigned char* lds) {
    const int tid = lt_tid(), lane = tid & 63;
    const int w = __builtin_amdgcn_readfirstlane(tid >> 6);
    LAS float* SG = (LAS float*)lds;
    const int sbid = lt_bid(), sgrid = lt_grid();
    const bool balanced = (sgrid == 256);
    for (int ti = 0; ti < 3; ++ti) {
        int task;
        if (balanced) {
            if (sbid < 32) { if (ti == 0) task = sbid; else break; }
            else { const int q = sbid - 32;
                const int st = q + 224 * ti; if (st >= 512) break; task = 32 + st; }
        } else { task = sbid + ti * sgrid; if (task >= 544) break; }
        __syncthreads();
        if (task >= 32) {
            const int idx = (task - 32) * 64 + lane; const int dir = idx >> 14, h = (idx >> 12) & 3;
            const float* SST = (const float*)(A.ws + OFF_SST) + idx; const float* SDEC = (const float*)(A.ws + OFF_SDEC) + dir * 4 + h; bf16* SENT = (bf16*)(A.ws + OFF_SENT) + idx;
            const int j0 = w * 33, nj = (j0 + 33 <= NCH) ? 33 : NCH - j0;
            float s = 0.f, dp = 1.f;
#pragma unroll 1
            for (int jb = 0; jb < 33; jb += 11) {
                float d[11], v[11];
#pragma unroll
                for (int q = 0; q < 11; ++q) { const int j = j0 + jb + q; const int jc = j < NCH ? j : NCH - 1; const int c = dir ? (jc < 4 ? 3 - jc : 263 - jc) : jc; d[q] = SDEC[c * 8]; v[q] = SST[(size_t)c * 32768]; }
#pragma unroll
                for (int q = 0; q < 11; ++q) if (jb + q < nj) { s = s * d[q] + v[q]; dp *= d[q]; }
            }
            SG[(w * 4 + 0) * 64 + lane] = s; SG[(w * 4 + 1) * 64 + lane] = dp;
            __syncthreads();
            float cin = 0.f;
            for (int k = 0; k < w; ++k) cin = cin * SG[(k * 4 + 1) * 64 + lane] + SG[(k * 4 + 0) * 64 + lane];
            s = cin;
#pragma unroll 1
            for (int jb = 0; jb < 33; jb += 11) {
                float d[11], v[11];
#pragma unroll
                for (int q = 0; q < 11; ++q) { const int j = j0 + jb + q; const int jc = j < NCH ? j : NCH - 1; const int c = dir ? (jc < 4 ? 3 - jc : 263 - jc) : jc; d[q] = SDEC[c * 8]; v[q] = SST[(size_t)c * 32768]; }
#pragma unroll
                for (int q = 0; q < 11; ++q) if (jb + q < nj) { const int j = j0 + jb + q; const int c = dir ? (j < 4 ? 3 - j : 263 - j) : j; SENT[(size_t)c * 32768] = (bf16)f2bf(s); s = s * d[q] + v[q]; }
            }
        } else {
            const int e = task, dir = e >> 4, g = e & 15;
            const float* lt = (const float*)(A.ws + OFF_LAMT) + ((size_t)((layer * 2 + dir) * 16 + g) * 64 + lane) * 2;
            const float lr = lt[0], li = lt[1];
            const size_t eo = (size_t)g * 256 + dir * 128 + lane;
            const float* E = (const float*)(A.ws + OFF_E) + eo; bf16* XSB = (bf16*)(A.ws + OFF_XS) + eo;
            const int j0 = w * 130;
            float sr = 0.f, si = 0.f, dr = 1.f, di = 0.f;
#pragma unroll 1
            for (int jb = 0; jb < 130; jb += 13) {
                float er[13], ei[13];
#pragma unroll
                for (int q = 0; q < 13; ++q) { const int j = j0 + jb + q; const int c = dir ? (j < 16 ? 15 - j : 1055 - j) : j; er[q] = E[(size_t)c * 4096]; ei[q] = E[(size_t)c * 4096 + 64]; }
#pragma unroll
                for (int q = 0; q < 13; ++q) { const float tr = lr * sr - li * si + er[q]; si = lr * si + li * sr + ei[q]; sr = tr;
                    const float t2 = lr * dr - li * di; di = lr * di + li * dr; dr = t2; }
            }
            SG[(w * 4 + 0) * 64 + lane] = sr; SG[(w * 4 + 1) * 64 + lane] = si; SG[(w * 4 + 2) * 64 + lane] = dr; SG[(w * 4 + 3) * 64 + lane] = di;
            __syncthreads();
            float cr = 0.f, ci = 0.f;
            for (int k = 0; k < w; ++k) { const float pr = SG[(k * 4 + 2) * 64 + lane], pi = SG[(k * 4 + 3) * 64 + lane];
                const float tr = pr * cr - pi * ci + SG[(k * 4 + 0) * 64 + lane]; ci = pr * ci + pi * cr + SG[(k * 4 + 1) * 64 + lane]; cr = tr; }
            sr = cr; si = ci;
#pragma unroll 1
            for (int jb = 0; jb < 130; jb += 13) {
                float er[13], ei[13];
#pragma unroll
                for (int q = 0; q < 13; ++q) { const int j = j0 + jb + q; const int c = dir ? (j < 16 ? 15 - j : 1055 - j) : j; er[q] = E[(size_t)c * 4096]; ei[q] = E[(size_t)c * 4096 + 64]; }
#pragma unroll
                for (int q = 0; q < 13; ++q) { const int j = j0 + jb + q; const int c = dir ? (j < 16 ? 15 - j : 1055 - j) : j;
                    XSB[(size_t)c * 4096] = (bf16)f2bf(sr); XSB[(size_t)c * 4096 + 64] = (bf16)f2bf(si);
                    const float tr = lr * sr - li * si + er[q]; si = lr * si + li * sr + ei[q]; sr = tr; }
            }
        }
    }
}

#ifndef R_ATT
#define R_ATT 1
#endif
#ifndef R_SSM
#define R_SSM 1
#endif
#ifndef R_SSMA
#define R_SSMA R_SSM
#endif
#ifndef R_SCAN
#define R_SCAN R_SSM
#endif
#ifndef R_SSMC
#define R_SSMC R_SSM
#endif
#ifndef R_GRES
#define R_GRES 1
#endif
#ifndef R_GLU
#define R_GLU 1
#endif
#ifndef R_SSDC
#define R_SSDC 1
#endif
#ifndef R_S5C
#define R_S5C 1
#endif
#ifndef R_GIN
#define R_GIN 1
#endif
#ifndef R_GFFN
#define R_GFFN 1
#endif
#ifndef R_NORM
#define R_NORM 1
#endif
#ifndef R_SETUP
#define R_SETUP 1
#endif
#define REPL(n) _Pragma("unroll 1") for (int rr_ = 0; rr_ < (n); ++rr_)
#ifndef XSYNC
#define XSYNC 0
#endif
#ifndef PHSEL
#define PHSEL 0xffff
#endif
constexpr int N_PHASES = 2 + 10 * DEPTH;
__global__ void __launch_bounds__(NTHREADS, 2) fwd_megakernel(Args KA) {
    extern __shared__ __attribute__((aligned(16))) unsigned char lds_raw[];
    LAS unsigned char* lds = (LAS unsigned char*)lds_raw;
    cg::grid_group grid = cg::this_grid();
    if (threadIdx.x < 8) ((LAS unsigned*)(lds + 131072 + 64))[threadIdx.x] = 0u;
    __syncthreads();
    XcdBarrier xbar = xcd_barrier_post((unsigned*)(KA.ws + OFF_BAR), (volatile LAS unsigned*)(lds + 131072 + 64));
#define LOAD_PA() __attribute__((address_space(4))) const unsigned char* kp = (__attribute__((address_space(4))) const unsigned char*)__builtin_amdgcn_kernarg_segment_ptr(); asm volatile("" : "+s"(kp)); \
        PA A; A.in = (in_tab_t)kp; A.out = *(fpp_t)(kp + 264); A.ws = *(ucpp_t)(kp + 272)
#define XBAR() do { XcdBarrier xb2 = xbar; asm volatile("" : "+s"(xb2.bar)); xcd_barrier(xb2); } while (0)
    int ph = KA.ph_lo;
    if (ph == 0 && ph < KA.ph_hi) { LOAD_PA(); if (PHSEL & 1) REPL(R_SETUP) phase_setup1(A, lds); if (ph + 1 < KA.ph_hi) { if (KA.ph_lo < 0) grid.sync(); else XBAR(); } ++ph; }
    if (ph == 1 && ph < KA.ph_hi) { LOAD_PA(); if (PHSEL & 2) REPL(R_SETUP) phase_setup2(A); if (ph + 1 < KA.ph_hi) XBAR(); ++ph; }
#pragma unroll 1
    for (; ph < KA.ph_hi; ++ph) {
        LOAD_PA();
        unsigned char* ws = A.ws;
        const int G = lt_grid(), bid = lt_bid();
        const int tid = lt_tid(), lane = tid & 63, wave = tid >> 6;
        {
            const int L = (ph - 2) / 10, k = (ph - 2) % 10;
            const float* modl = (const float*)(ws + OFF_MOD) + (size_t)(L * 2) * 6144; const float* modc = modl + 6144;
            if (k == 0) { if (PHSEL & 4) REPL(R_NORM) phase_modnorm(A, L, 0); }
            else if (k == 1) {
                pg8::Gemm g{(const bf16*)(ws + OFF_H), (const bf16*)(ws + OFF_WIN + L * SZ_WIN), MR, NIN, DM}; pg8::StaticOrder S; S.init(MR, NIN, G, bid); S.nkt = DM / 64;
                EpiIn E{(bf16*)(ws + OFF_ZB), (bf16*)(ws + OFF_XBC), (bf16*)(ws + OFF_UB), (bf16*)(ws + OFF_QB), (bf16*)(ws + OFF_KB), (bf16*)(ws + OFF_VB), (float*)(ws + OFF_DTB),
                        A.in[I_QN] + L * 32, A.in[I_KN] + L * 32, A.in[I_DTBIAS] + L * 8, (const float*)(ws + OFF_ROPE)};
                if (PHSEL & 8) REPL(R_GIN) pg8::gemm_phase<EpiIn, pg8::StaticOrder, true, true>(lds, g, S, E);
            } else if (k == 2) {
                REPL(R_SSMA) {
                    if (bid < NCH) ssd_states_item(A, L, bid, lds);
                    if (bid + G < NCH) ssd_states_item(A, L, bid + G, lds);
                    else { const int nb = G - (NCH - G), b2 = bid - (NCH - G);
                        if (nb >= 252) { if (b2 < 252) s5_e_block(A, L, b2, lds); }
                        else for (int it = b2 * 8 + wave; it < 65 * 32; it += nb * 8) s5_e_item(A, L, it >> 5, (it >> 1) & 15, it & 1, lane); }
                }
            } else if (k == 3) { if (PHSEL & 64) REPL(R_SCAN) phase_scan(A, L, lds); }
            else if (k == 4) {
                REPL(R_SSMC) {
                    REPL(R_SSDC) { if (bid < NCH) ssd_out_item(A, L, bid, lds);
                    if (bid + G < NCH) ssd_out_item(A, L, bid + G, lds); }
                    if (!(bid + G < NCH)) REPL(R_S5C) { const int nb = G - (NCH - G), b2 = bid - (NCH - G);
                        if (nb >= 252) { if (b2 < 252) s5_y_block(A, L, b2, lds); }
                        else for (int it = b2 * 8 + wave; it < 65 * 32; it += nb * 8) s5_y_item(A, L, it >> 5, (it >> 1) & 15, it & 1, lane); }
                }
            } else if (k == 5) {
                if (bid >= G - 65) {
                    pg8::Gemm g{(const bf16*)(ws + OFF_YG), (const bf16*)(ws + OFF_GLU + L * SZ_GLU), MR, 256, 256}; pg8::StaticOrder S; S.init(MR, 256, 65, bid - (G - 65)); S.nkt = 4;
                    EpiGlu E{(const bf16*)(ws + OFF_YG), (bf16*)(ws + OFF_MIX), A.in[I_GLUB] + L * 256};
                    if (PHSEL & 512) REPL(R_GLU) pg8::gemm_phase<EpiGlu, pg8::StaticOrder, false, true>(lds, g, S, E);
                }
                if (PHSEL & 1024) REPL(R_ATT) phase_attn(A, L, lds);
            } else if (k == 6) {
                pg8::Gemm g{(const bf16*)(ws + OFF_MIX), (const bf16*)(ws + OFF_WOUT + L * SZ_WOUT), MR, DM, DM}; SplitOrder S; S.init(G, bid, DM / 64, 4, L < DEPTH - 1);
                EpiRes E{A.out, (float*)(ws + OFF_XC), modl + 2 * DM, modc + 2 * DM, 1.0f / R_GRES};
                if (PHSEL & 2048) REPL(R_GRES) pg8::gemm_phase<EpiRes, SplitOrder, true, true>(lds, g, S, E);
            } else if (k == 7) { if (PHSEL & 4) REPL(R_NORM) phase_modnorm(A, L, 1); }
            else if (k == 8) {
                pg8::Gemm g{(const bf16*)(ws + OFF_H), (const bf16*)(ws + OFF_W13 + L * SZ_W13), MR, NFF2, DM}; pg8::StaticOrder S; S.init(MR, NFF2, G, bid); S.nkt = DM / 64;
                EpiFfn E{(bf16*)(ws + OFF_FFU)};
                if (PHSEL & 4096) REPL(R_GFFN) pg8::gemm_phase<EpiFfn, pg8::StaticOrder, true, true>(lds, g, S, E);
            } else {
                pg8::Gemm g{(const bf16*)(ws + OFF_FFU), (const bf16*)(ws + OFF_W2 + L * SZ_W2), MR, DM, DFF}; SplitOrder S; S.init(G, bid, DFF / 64, 11, L < DEPTH - 1);
                EpiRes E{A.out, (float*)(ws + OFF_XC), modl + 5 * DM, modc + 5 * DM, 1.0f / R_GRES};
                if (PHSEL & 2048) REPL(R_GRES) pg8::gemm_phase<EpiRes, SplitOrder, true, true>(lds, g, S, E);
            }
        }
        for (int xs = 0; xs < XSYNC; ++xs) XBAR();
        if (ph + 1 < KA.ph_hi) XBAR();
    }
}

#ifndef N_LAUNCH_SPLIT
#define N_LAUNCH_SPLIT 0
#endif
static_assert(offsetof(Args, out) == 264 && offsetof(Args, ws) == 272, "Args layout");
extern "C" void kernel_launch(void* const* d_in, const int* in_sizes, int n_in, void* d_out, int out_size, void* d_ws, size_t ws_size, hipStream_t stream) {
    static int grid = 0;
    if (grid == 0) {
        if (n_in != 33 || out_size != SEQ * DM || ws_size < WS_END) { fprintf(stderr, "kernel_launch: unexpected shapes: n_in %d out %d ws %zu (need %zu)\n", n_in, out_size, ws_size, (size_t)WS_END); grid = -1; return; }
        int dev = 0, cus = 0, per_cu = 0;
        (void)hipGetDevice(&dev); (void)hipDeviceGetAttribute(&cus, hipDeviceAttributeMultiprocessorCount, dev);
        (void)hipFuncSetAttribute((const void*)fwd_megakernel, hipFuncAttributeMaxDynamicSharedMemorySize, LDS_BYTES);
        (void)hipOccupancyMaxActiveBlocksPerMultiprocessor(&per_cu, (const void*)fwd_megakernel, NTHREADS, LDS_BYTES);
        fprintf(stderr, "kernel_launch: cus %d, blocks/CU %d, ws %zu need %zu\n", cus, per_cu, ws_size, (size_t)WS_END);
        (void)hipGetLastError();
        grid = cus > 0 ? cus : 256;
    }
    if (grid < 0) return;
    (void)hipMemsetAsync((unsigned char*)d_ws + OFF_BAR, 0, BAR_BYTES, stream);
    Args a{};
    for (int i = 0; i < 33; ++i) a.in[i] = (const float*)d_in[i];
    a.out = (float*)d_out; a.ws = (unsigned char*)d_ws;
#if N_LAUNCH_SPLIT
    for (int ph = 0; ph < N_PHASES; ++ph) { a.ph_lo = ph; a.ph_hi = ph + 1; void* args[] = {&a};
        hipError_t e = hipLaunchCooperativeKernel((const void*)fwd_megakernel, dim3(grid), dim3(NTHREADS), args, LDS_BYTES, stream);
        if (e != hipSuccess) { fprintf(stderr, "cooperative launch failed: %s\n", hipGetErrorString(e)); break; } }
#else
    a.ph_lo = 0; a.ph_hi = N_PHASES; void* args[] = {&a};
    hipError_t e = hipLaunchCooperativeKernel((const void*)fwd_megakernel, dim3(grid), dim3(NTHREADS), args, LDS_BYTES, stream);
    if (e != hipSuccess) fprintf(stderr, "cooperative launch failed: %s (grid %d)\n", hipGetErrorString(e), grid);
#endif
}
```

```cpp
#include <hip/hip_runtime.h>
#include <hip/hip_cooperative_groups.h>
#include <cstdio>
#include <cstdint>
#include <cmath>
#include <cstddef>
namespace cg = cooperative_groups;
__device__ __forceinline__ int lt_tid() { int t = threadIdx.x; asm volatile("" : "+v"(t)); return t; }
__device__ __forceinline__ int lt_bid() { int t = blockIdx.x; asm volatile("" : "+s"(t)); return t; }
__device__ __forceinline__ int lt_grid() { int t = gridDim.x; asm volatile("" : "+s"(t)); return t; }
namespace pg8 {
#define PG8_LAS __attribute__((address_space(3)))
typedef unsigned short bf16_t;
typedef short bf16x8 __attribute__((ext_vector_type(8)));
typedef float f32x4 __attribute__((ext_vector_type(4)));
typedef unsigned u32x4 __attribute__((ext_vector_type(4)));
constexpr int BM = 256, BK = 64, HALF = 128, HTB = HALF * BK * 2  , STAGE_BYTES = 8 * HTB, NXCD = 8, WGM = 8;

__host__ __device__ __forceinline__ int lds_byte(int r, int c) { const int st = (r >> 4) * 2 + (c >> 5), rr = r & 15, cc = c & 31, ob = rr * 64 + cc * 2; return st * 1024 + (ob ^ (((ob >> 9) & 1) << 5)); }
__host__ __device__ __forceinline__ void stage_rc(int b, int& R, int& C) { const int st = b / 1024, sb = b % 1024, swz = sb ^ (((sb >> 9) & 1) << 5); R = (st >> 1) * 16 + swz / 64; C = (st & 1) * 32 + (swz % 64) / 2; }
__host__ __device__ __forceinline__ int perm32(int rho) { const int n = rho >> 4, i = rho & 15; return 8 * (i >> 2) + 4 * n + (i & 3); }

struct Unit { int pm, pn, k0, nkt; };
struct Gemm { const bf16_t* A; const bf16_t* Bt; int M, N, K; };

struct StaticOrder {
    int nM, nN, nwg, G, c, nkt;
    __host__ __device__ void init(int M, int N, int G_, int c_) { nM = M / BM; nN = N / BM; nwg = nM * nN; G = G_; c = c_; }
    __host__ __device__ bool next(int i, Unit& u) const {
        const long L = (long)i * G + c; if (L >= nwg) return false;
        int wgid = (int)L; { const int q = nwg / NXCD, r = nwg % NXCD, xcd = wgid % NXCD, off = wgid / NXCD; wgid = (xcd < r ? xcd * (q + 1) : r * (q + 1) + (xcd - r) * q) + off; }
        const int nig = WGM * nN, gid = wgid / nig, fm = gid * WGM, gsz = (nM - fm) < WGM ? (nM - fm) : WGM;
        u.pm = fm + ((wgid % nig) % gsz); u.pn = (wgid % nig) / gsz; u.k0 = 0; u.nkt = nkt; return true;
    }
    __device__ __forceinline__ void a_ready(const Unit&) const {}
    __device__ __forceinline__ void done(const Unit&) const {}
};

__device__ __forceinline__ unsigned cvt_pk_bf16(float lo, float hi) { unsigned r; asm volatile("v_cvt_pk_bf16_f32 %0, %1, %2" : "=v"(r) : "v"(lo), "v"(hi)); return r; }
typedef float f32x2 __attribute__((ext_vector_type(2)));
template <class Epi, class Sched, bool ALIGN_EPI = false, bool SP2 = false>
__device__ __forceinline__ void gemm_phase(PG8_LAS unsigned char* lds, const Gemm g, const Sched& S, const Epi& E) {
    const int tid = lt_tid(), wid = __builtin_amdgcn_readfirstlane(tid >> 6), lane = tid & 63, wr = wid >> 2, wc = wid & 3, fr = lane & 15, fq = lane >> 4;
    int K = g.K; asm volatile("" : "+s"(K));
    unsigned voffA[2], voffB[2];
#pragma unroll
    for (int i = 0; i < 2; ++i) { int R, C; stage_rc(tid * 16 + i * 8192, R, C); const int Rb = Epi::PERM ? ((R & ~31) + perm32(R & 31)) : R;
        voffA[i] = (unsigned)(R * K + C) * 2u; voffB[i] = (unsigned)(Rb * K + C) * 2u; }
    const size_t kstep = (size_t)(BK * 2);
    const size_t hstep = (size_t)HALF * K * 2;
    const size_t tstep = 2 * hstep;
    const unsigned ldsw = (unsigned)wid * 1024u;
    const int aoff = lds_byte(wr * 64 + fr, fq * 8), boff = lds_byte(wc * 32 + fr, fq * 8);
#define PG8_SA(b, h) (((b) * 2 + (h)) * HTB)
#define PG8_SB(b, h) ((4 + (b) * 2 + (h)) * HTB)
#define PG8_STAGE(bufoff, gbase, voff) do { _Pragma("unroll") for (int _i = 0; _i < 2; ++_i) \
        __builtin_amdgcn_global_load_lds((const unsigned*)((const char*)(gbase) + (voff)[_i]), (PG8_LAS unsigned*)(lds + (bufoff) + ldsw + _i * 8192), 16, 0, 0); } while (0)
#define PG8_LDA(dst, b, h) do { _Pragma("unroll") for (int m = 0; m < 4; ++m) _Pragma("unroll") for (int k = 0; k < 2; ++k) dst[m][k] = *(const PG8_LAS bf16x8*)(lds + PG8_SA(b, h) + aoff + m * 2048 + k * 1024); } while (0)
#define PG8_LDB(dst, b, h) do { _Pragma("unroll") for (int n = 0; n < 2; ++n) _Pragma("unroll") for (int k = 0; k < 2; ++k) dst[n][k] = *(const PG8_LAS bf16x8*)(lds + PG8_SB(b, h) + boff + n * 2048 + k * 1024); } while (0)
#define PG8_MMA(ai, bj, At, Bt) do { __builtin_amdgcn_s_setprio(1); _Pragma("unroll") for (int m = 0; m < 4; ++m) _Pragma("unroll") for (int n = 0; n < 2; ++n) _Pragma("unroll") for (int k = 0; k < 2; ++k) \
        acc[ai][bj][m][n] = __builtin_amdgcn_mfma_f32_16x16x32_bf16(Bt[n][k], At[m][k], acc[ai][bj][m][n], 0, 0, 0); __builtin_amdgcn_s_setprio(0); } while (0)
#define PG8_WAIT_V(n) asm volatile("s_waitcnt vmcnt(" #n ")" ::: "memory")
#define PG8_WAIT_L(n) asm volatile("s_waitcnt lgkmcnt(" #n ")" ::: "memory")
#define PG8_BAR __builtin_amdgcn_s_barrier()
#define PG8_SCHED __builtin_amdgcn_sched_barrier(0)
    Unit cur, nxt; int ui = 0;
    if (!S.next(0, cur)) return;
    f32x4 acc[2][2][4][2];
#pragma unroll
    for (int a = 0; a < 2; ++a)
#pragma unroll
        for (int b = 0; b < 2; ++b)
#pragma unroll
            for (int m = 0; m < 4; ++m)
#pragma unroll
                for (int n = 0; n < 2; ++n) acc[a][b][m][n] = (f32x4){0.f, 0.f, 0.f, 0.f};
    bf16x8 At[4][2], B0[2][2], B1[2][2];
    const char* cA = (const char*)g.A + (size_t)cur.pm * tstep + (size_t)cur.k0 * 2; const char* cB = (const char*)g.Bt + (size_t)cur.pn * tstep + (size_t)cur.k0 * 2;
    S.a_ready(cur);
    if constexpr (SP2) {
        PG8_STAGE(PG8_SB(0, 0), cB, voffB); PG8_STAGE(PG8_SB(0, 1), cB + hstep, voffB); PG8_STAGE(PG8_SA(0, 0), cA, voffA); PG8_STAGE(PG8_SA(0, 1), cA + hstep, voffA);
        if (wr == 1) PG8_BAR;
        PG8_WAIT_V(2); PG8_BAR;
        PG8_STAGE(PG8_SB(1, 0), cB + kstep, voffB); PG8_STAGE(PG8_SA(1, 0), cA + kstep, voffA); PG8_STAGE(PG8_SB(1, 1), cB + hstep + kstep, voffB);
        PG8_WAIT_V(6); PG8_BAR;
    } else {
        PG8_STAGE(PG8_SB(0, 0), cB, voffB); PG8_STAGE(PG8_SA(0, 0), cA, voffA); PG8_STAGE(PG8_SB(0, 1), cB + hstep, voffB); PG8_STAGE(PG8_SA(0, 1), cA + hstep, voffA);
        if (wr == 1) PG8_BAR;
        PG8_WAIT_V(4); PG8_BAR;
        PG8_STAGE(PG8_SB(1, 0), cB + kstep, voffB); PG8_STAGE(PG8_SA(1, 0), cA + kstep, voffA); PG8_STAGE(PG8_SB(1, 1), cB + hstep + kstep, voffB);
        PG8_WAIT_V(6); PG8_BAR;
    }
    for (;;) {
        const bool has_next = S.next(ui + 1, nxt);
        const char* nA = has_next ? (const char*)g.A + (size_t)nxt.pm * tstep + (size_t)nxt.k0 * 2 : cA; const char* nB = has_next ? (const char*)g.Bt + (size_t)nxt.pn * tstep + (size_t)nxt.k0 * 2 : cB;
        const int nt = cur.nkt;
        for (int t = 0; t < nt; t += 2) {
            const bool last = (t == nt - 2);
            const char* a1 = cA + (size_t)(t + 1) * kstep;
            const char* a2 = last ? nA : cA + (size_t)(t + 2) * kstep; const char* b2 = last ? nB : cB + (size_t)(t + 2) * kstep;
            const char* a3 = a2 + kstep; const char* b3 = b2 + kstep;
            if (last && has_next) S.a_ready(nxt);
            if constexpr (SP2) {
            PG8_LDB(B0, 0, 0); PG8_LDB(B1, 0, 1); PG8_SCHED; PG8_LDA(At, 0, 0); PG8_STAGE(PG8_SA(1, 1), a1 + hstep, voffA);
            PG8_WAIT_V(8); PG8_WAIT_L(0); PG8_BAR; PG8_MMA(0, 0, At, B0); PG8_MMA(0, 1, At, B1); PG8_BAR; PG8_SCHED;
            PG8_LDA(At, 0, 1); PG8_STAGE(PG8_SB(0, 0), b2, voffB); PG8_STAGE(PG8_SB(0, 1), b2 + hstep, voffB); PG8_STAGE(PG8_SA(0, 0), a2, voffA);
            PG8_WAIT_V(8); PG8_WAIT_L(0); PG8_BAR; PG8_MMA(1, 0, At, B0); PG8_MMA(1, 1, At, B1); PG8_BAR; PG8_SCHED;
            PG8_LDB(B0, 1, 0); PG8_LDB(B1, 1, 1); PG8_SCHED; PG8_LDA(At, 1, 0); PG8_STAGE(PG8_SA(0, 1), a2 + hstep, voffA);
            PG8_WAIT_V(8); PG8_WAIT_L(0); PG8_BAR; PG8_MMA(0, 0, At, B0); PG8_MMA(0, 1, At, B1); PG8_BAR; PG8_SCHED;
            PG8_LDA(At, 1, 1); PG8_STAGE(PG8_SB(1, 0), b3, voffB); PG8_STAGE(PG8_SB(1, 1), b3 + hstep, voffB); PG8_STAGE(PG8_SA(1, 0), a3, voffA);
            PG8_WAIT_V(8); PG8_WAIT_L(0); PG8_BAR; PG8_MMA(1, 0, At, B0); PG8_MMA(1, 1, At, B1); PG8_BAR; PG8_SCHED;
            } else {
            PG8_LDB(B0, 0, 0); PG8_SCHED; PG8_LDA(At, 0, 0); PG8_STAGE(PG8_SA(1, 1), a1 + hstep, voffA);
            PG8_WAIT_L(8); PG8_BAR; PG8_WAIT_L(0); PG8_MMA(0, 0, At, B0); PG8_BAR; PG8_SCHED;
            PG8_LDB(B1, 0, 1); PG8_STAGE(PG8_SB(0, 0), b2, voffB);
            PG8_BAR; PG8_WAIT_L(0); PG8_MMA(0, 1, At, B1); PG8_BAR;
            PG8_LDA(At, 0, 1); PG8_STAGE(PG8_SA(0, 0), a2, voffA);
            PG8_BAR; PG8_WAIT_L(0); PG8_MMA(1, 0, At, B0); PG8_BAR; PG8_SCHED;
            PG8_STAGE(PG8_SB(0, 1), b2 + hstep, voffB);
            PG8_WAIT_V(6); PG8_BAR; PG8_MMA(1, 1, At, B1); PG8_BAR;
            PG8_LDB(B0, 1, 0); PG8_SCHED; PG8_LDA(At, 1, 0); PG8_STAGE(PG8_SA(0, 1), a2 + hstep, voffA);
            PG8_WAIT_L(8); PG8_BAR; PG8_WAIT_L(0); PG8_MMA(0, 0, At, B0); PG8_BAR; PG8_SCHED;
            PG8_LDB(B1, 1, 1); PG8_STAGE(PG8_SB(1, 0), b3, voffB);
            PG8_BAR; PG8_WAIT_L(0); PG8_MMA(0, 1, At, B1); PG8_BAR;
            PG8_LDA(At, 1, 1); PG8_STAGE(PG8_SA(1, 0), a3, voffA);
            PG8_BAR; PG8_WAIT_L(0); PG8_MMA(1, 0, At, B0); PG8_BAR; PG8_SCHED;
            PG8_STAGE(PG8_SB(1, 1), b3 + hstep, voffB);
            PG8_WAIT_V(6); PG8_BAR; PG8_MMA(1, 1, At, B1); PG8_BAR;
            }
        }
        if constexpr (ALIGN_EPI) { if (wr == 0) PG8_BAR; }
        if constexpr (!Epi::AFTER_DRAIN) { E(acc, cur, wr, wc, fr, fq); S.done(cur); }
        if (!has_next) break;
#pragma unroll
        for (int a = 0; a < 2; ++a)
#pragma unroll
            for (int b = 0; b < 2; ++b)
#pragma unroll
                for (int m = 0; m < 4; ++m)
#pragma unroll
                    for (int n = 0; n < 2; ++n) acc[a][b][m][n] = (f32x4){0.f, 0.f, 0.f, 0.f};
        cur = nxt; cA = nA; cB = nB; ++ui;
        if constexpr (ALIGN_EPI) { if (wr == 1) PG8_BAR; }
    }
    PG8_WAIT_V(0);
    if constexpr (!ALIGN_EPI) { if (wr == 0) PG8_BAR; }
    PG8_BAR;
    if constexpr (Epi::AFTER_DRAIN) { E.fused(acc, cur, wr, wc, fr, fq, lds, wid, lane); S.done(cur); }
#undef PG8_SA
#undef PG8_SB
#undef PG8_STAGE
#undef PG8_LDA
#undef PG8_LDB
#undef PG8_MMA
#undef PG8_WAIT_V
#undef PG8_WAIT_L
#undef PG8_BAR
#undef PG8_SCHED
}
}

#define LAS __attribute__((address_space(3)))
typedef unsigned short bf16;
typedef short bf16x8 __attribute__((ext_vector_type(8)));
typedef short s16x4 __attribute__((ext_vector_type(4)));
typedef short v4i16_t __attribute__((ext_vector_type(4)));
typedef float f32x2 __attribute__((ext_vector_type(2)));
typedef float f32x4 __attribute__((ext_vector_type(4)));
typedef float f32x16 __attribute__((ext_vector_type(16)));
typedef unsigned u32x2 __attribute__((ext_vector_type(2)));
typedef unsigned u32x4 __attribute__((ext_vector_type(4)));
typedef __bf16 bf16x2_t __attribute__((ext_vector_type(2)));

constexpr int DM = 1024, SEQ = 16384, CTX = 256, MR = SEQ + CTX, DEPTH = 4;
constexpr int NIN = 2816, INW = 2568, DFF = 2816, NFF2 = 5632;
constexpr float EPS = 1e-6f;
constexpr int NCH = MR / 64;
constexpr int NC5 = MR / 16;
constexpr int NTHREADS = 512;
constexpr int LDS_BYTES = 147456;

constexpr size_t al256(size_t x) { return (x + 255) & ~(size_t)255; }
constexpr size_t SZ_WIN = (size_t)NIN * DM * 2, SZ_WOUT = (size_t)DM * DM * 2, SZ_W13 = (size_t)NFF2 * DM * 2, SZ_W2 = (size_t)DM * DFF * 2, SZ_GLU = 256 * 256 * 2;
constexpr size_t SZ_BTE = (size_t)16 * 256 * 256 * 2, SZ_BTY = (size_t)16 * 256 * 512 * 2;
constexpr size_t OFF_WIN = 0;
constexpr size_t OFF_WOUT = OFF_WIN + DEPTH * SZ_WIN;
constexpr size_t OFF_W13 = OFF_WOUT + DEPTH * SZ_WOUT;
constexpr size_t OFF_W2 = OFF_W13 + DEPTH * SZ_W13;
constexpr size_t OFF_GLU = OFF_W2 + DEPTH * SZ_W2;
constexpr size_t OFF_BTE = OFF_GLU + DEPTH * SZ_GLU;
constexpr size_t OFF_BTY = OFF_BTE + DEPTH * SZ_BTE;
constexpr size_t OFF_KF = OFF_BTY + DEPTH * SZ_BTY;
constexpr size_t OFF_LAMT = OFF_KF + (size_t)DEPTH * 2 * 16 * 4096 * 4;
constexpr size_t OFF_POWT = OFF_LAMT + (size_t)DEPTH * 2 * 16 * 64 * 2 * 4;
constexpr size_t OFF_QF = OFF_POWT + (size_t)DEPTH * 2 * 16 * 64 * 17 * 2 * 4;
constexpr size_t OFF_MODP = OFF_QF + (size_t)DEPTH * 2 * 16 * 64 * 2 * 4;
constexpr size_t OFF_MOD = OFF_MODP + (size_t)DEPTH * 16 * 2 * 6144 * 4;
constexpr size_t OFF_ROPE = OFF_MOD + (size_t)DEPTH * 2 * 6144 * 4;
constexpr size_t OFF_XC = OFF_ROPE + 256 * 16 * 4;
constexpr size_t OFF_H = OFF_XC + (size_t)CTX * DM * 4;
constexpr size_t OFF_SST = OFF_H;
constexpr size_t OFF_ZB = OFF_H + (size_t)MR * DM * 2;
constexpr size_t OFF_XBC = OFF_ZB + (size_t)MR * 256 * 2;
constexpr size_t OFF_UB = OFF_XBC + (size_t)MR * 512 * 2;
constexpr size_t OFF_QB = OFF_UB + (size_t)MR * 256 * 2;
constexpr size_t OFF_KB = OFF_QB + (size_t)MR * 512 * 2;
constexpr size_t OFF_VB = OFF_KB + (size_t)MR * 512 * 2;
constexpr size_t OFF_DTB = OFF_VB + (size_t)MR * 512 * 2;
constexpr size_t OFF_MIX = OFF_DTB + (size_t)MR * 8 * 4;
constexpr size_t OFF_ACT_END = OFF_MIX + (size_t)MR * DM * 2;
constexpr size_t OFF_FFU = OFF_ZB;
static_assert(OFF_FFU + (size_t)MR * DFF * 2 <= OFF_ACT_END, "FFU overlay");
static_assert((size_t)NCH * 32768 * 4 <= (size_t)MR * DM * 2, "SST overlay");
constexpr size_t OFF_SENT = OFF_ACT_END;
constexpr size_t OFF_SDEC = OFF_SENT + (size_t)NCH * 32768 * 2;
constexpr size_t OFF_E = al256(OFF_SDEC + NCH * 8 * 4);
constexpr size_t OFF_XS = OFF_E + (size_t)NC5 * 4096 * 4;
constexpr size_t OFF_YG = OFF_XS + (size_t)NC5 * 4096 * 2;
constexpr size_t OFF_XACT = al256(OFF_YG + (size_t)MR * 256 * 2);
constexpr size_t OFF_BAR = al256(OFF_XACT + (size_t)MR * 512 * 2);
constexpr size_t BAR_BYTES = 16384;
constexpr size_t WS_END = OFF_BAR + BAR_BYTES;

struct Args {
    const float* in[33];
    float* out; unsigned char* ws;
    int ph_lo, ph_hi;
};
typedef const float* cfp_t;
typedef __attribute__((address_space(4))) const cfp_t* in_tab_t;
typedef float* fp_t; typedef unsigned char* ucp_t;
typedef __attribute__((address_space(4))) const fp_t* fpp_t; typedef __attribute__((address_space(4))) const ucp_t* ucpp_t;
struct PA { in_tab_t in; float* out; unsigned char* ws; };
enum { I_X = 0, I_C, I_CTX, I_CCTX, I_WMOD, I_BMOD, I_NORM1, I_NORM2, I_WIN, I_WOUT, I_CONVW, I_CONVB, I_ALOG, I_DTBIAS, I_SSDD, I_SSDNORM,
       I_LRE, I_LIM, I_LSTEP, I_BRE, I_BIM, I_CRE, I_CIM, I_S5D, I_GLUW, I_GLUB, I_QN, I_KN, I_DALAM, I_SUBN, I_W1, I_W3, I_W2 };

__device__ __forceinline__ unsigned cvtpk(float lo, float hi);
__device__ __forceinline__ unsigned f2bf(float f) { return cvtpk(f, 0.f) & 0xffffu; }
__device__ __forceinline__ float bf2f(unsigned short b) { return __builtin_bit_cast(float, (unsigned)b << 16); }
__device__ __forceinline__ unsigned cvtpk(float lo, float hi) { f32x2 v = {lo, hi}; bf16x2_t b = __builtin_convertvector(v, bf16x2_t); return __builtin_bit_cast(unsigned, b); }
__device__ __forceinline__ float wave_sum(float v) {
#pragma unroll
    for (int o = 1; o < 64; o <<= 1) v += __shfl_xor(v, o);
    return v;
}
__device__ __forceinline__ float siluf(float v) { return v * __builtin_amdgcn_rcpf(1.f + __expf(-v)); }
__device__ __forceinline__ float sigmf(float v) { return __builtin_amdgcn_rcpf(1.f + __expf(-v)); }
__device__ __forceinline__ int crow(int r, int hi) { return (r & 3) + 8 * (r >> 2) + 4 * hi; }
__device__ __forceinline__ s16x4 vtr(const LAS unsigned char* p) { return __builtin_bit_cast(s16x4, __builtin_amdgcn_ds_read_tr16_b64_v4i16((LAS v4i16_t*)p)); }
__device__ __forceinline__ bf16x8 cat8(s16x4 lo, s16x4 hi) { return __builtin_shufflevector(lo, hi, 0, 1, 2, 3, 4, 5, 6, 7); }
__device__ __forceinline__ bf16x8 pack8(const f32x16& x, int s) {
    u32x4 p; p.x = cvtpk(x[8 * s], x[8 * s + 1]); p.y = cvtpk(x[8 * s + 2], x[8 * s + 3]); p.z = cvtpk(x[8 * s + 4], x[8 * s + 5]); p.w = cvtpk(x[8 * s + 6], x[8 * s + 7]);
    return __builtin_bit_cast(bf16x8, p);
}
#ifndef WT_STORES
#define WT_STORES 0
#endif
__device__ __forceinline__ void st16_wt(void* p, u32x4 v) {
#if WT_STORES
    __builtin_nontemporal_store(v, (u32x4*)p);
#else
    *(u32x4*)p = v;
#endif
}
__device__ __forceinline__ void st8_wt(void* p, u32x2 v) {
#if WT_STORES
    __builtin_nontemporal_store(v, (u32x2*)p);
#else
    *(u32x2*)p = v;
#endif
}
#define MFMA32(a, b, c) __builtin_amdgcn_mfma_f32_32x32x16_bf16((a), (b), (c), 0, 0, 0)
#define MFMA16(a, b, c) __builtin_amdgcn_mfma_f32_16x16x32_bf16((a), (b), (c), 0, 0, 0)

__device__ __forceinline__ void transpose_item(const float* src, int ldn, bf16* WT, int K, int n0, int k0, LAS float* scr, int lane) {
    float tv[32];
#pragma unroll
    for (int i = 0; i < 32; ++i) { const int kk = 2 * i + (lane >> 5); tv[i] = src ? src[(size_t)kk * ldn] : 0.f; }
#pragma unroll
    for (int i = 0; i < 32; ++i) { const int kk = 2 * i + (lane >> 5); scr[kk * 33 + (lane & 31)] = tv[i]; }
    asm volatile("s_waitcnt lgkmcnt(0)" ::: "memory");
    const int c = lane & 7;
#pragma unroll
    for (int j = 0; j < 4; ++j) { const int n = (lane >> 3) + 8 * j; const LAS float* s = scr + (8 * c) * 33 + n;
        u32x4 o; o.x = cvtpk(s[0 * 33], s[1 * 33]); o.y = cvtpk(s[2 * 33], s[3 * 33]); o.z = cvtpk(s[4 * 33], s[5 * 33]); o.w = cvtpk(s[6 * 33], s[7 * 33]);
        *(u32x4*)(WT + (size_t)(n0 + n) * K + k0 + 8 * c) = o; }
    asm volatile("s_waitcnt lgkmcnt(0)" ::: "memory");
}

constexpr int TR_IN = 16 * 88, TR_OUT = 16 * 32, TR_13 = 16 * 176, TR_2 = 44 * 32, TR_G = 4 * 8;
constexpr int TR_A = TR_IN + TR_OUT + TR_G;
constexpr int TR_ITEMS = TR_A + TR_13 + TR_2;
__device__ __forceinline__ void transpose_task(const PA& A, int l, int r, LAS float* scr, int lane) {
    unsigned char* ws = A.ws;
    if (r < TR_IN) { const int kb = r / 88, nb = r % 88, n = nb * 32 + (lane & 31);
        int sc; if (n < 768) sc = n; else if (n < 2560) sc = n + 8; else if (n < 2568) sc = 768 + (n - 2560); else sc = -1;
        const float* W = A.in[I_WIN] + (size_t)l * DM * INW;
        transpose_item(sc >= 0 ? W + (size_t)(kb * 64) * INW + sc : nullptr, INW, (bf16*)(ws + OFF_WIN + l * SZ_WIN), DM, nb * 32, kb * 64, scr, lane); return; }
    r -= TR_IN;
    if (r < TR_OUT) { const int kb = r / 32, nb = r % 32; const float* W = A.in[I_WOUT] + (size_t)l * DM * DM;
        transpose_item(W + (size_t)(kb * 64) * DM + nb * 32 + (lane & 31), DM, (bf16*)(ws + OFF_WOUT + l * SZ_WOUT), DM, nb * 32, kb * 64, scr, lane); return; }
    r -= TR_OUT;
    if (r < TR_G) { const int kb = r / 8, nb = r % 8; const float* W = A.in[I_GLUW] + (size_t)l * 256 * 256;
        transpose_item(W + (size_t)(kb * 64) * 256 + nb * 32 + (lane & 31), 256, (bf16*)(ws + OFF_GLU + l * SZ_GLU), 256, nb * 32, kb * 64, scr, lane); return; }
    r -= TR_G;
    if (r < TR_13) { const int kb = r / 176, nb = r % 176, n = nb * 32 + (lane & 31); const int pn = n >> 8, bj = (n >> 7) & 1, i = n & 127;
        const float* W = (bj ? A.in[I_W3] : A.in[I_W1]) + (size_t)l * DM * DFF;
        transpose_item(W + (size_t)(kb * 64) * DFF + pn * 128 + i, DFF, (bf16*)(ws + OFF_W13 + l * SZ_W13), DM, nb * 32, kb * 64, scr, lane); return; }
    r -= TR_13;
    { const int kb = r / 32, nb = r % 32; const float* W = A.in[I_W2] + (size_t)l * DFF * DM;
        transpose_item(W + (size_t)(kb * 64) * DM + nb * 32 + (lane & 31), DM, (bf16*)(ws + OFF_W2 + l * SZ_W2), DFF, nb * 32, kb * 64, scr, lane); }
}
__device__ __forceinline__ void phase_setup1(const PA& A, LAS unsigned char* lds) {
    const int tid = lt_tid(), lane = tid & 63, wave = tid >> 6;
    const int gw = lt_bid() * 8 + wave, NGW = lt_grid() * 8;
    const int gt = lt_bid() * NTHREADS + tid, GT = lt_grid() * NTHREADS;
    unsigned char* ws = A.ws;
    LAS float* scr = (LAS float*)(lds + wave * 16384);
    { const int nl = DEPTH;
      for (int it = gw; it < nl * TR_ITEMS; it += NGW) transpose_task(A, it / TR_ITEMS, it % TR_ITEMS, scr, lane); }
    for (int it = gw; it < DEPTH * 16 * 24; it += NGW) {
        const int l = it / 384, r = it % 384, ks = r / 24, ng = r % 24;
        const float* W = A.in[I_WMOD] + ((size_t)l * DM + ks * 64) * 6144 + ng * 256 + 4 * lane;
        const float cv = A.in[I_C][ks * 64 + lane], cc = A.in[I_CCTX][ks * 64 + lane];
        const float sl = siluf(cv), sc = siluf(cc);
        f32x4 aL = {0, 0, 0, 0}, aC = {0, 0, 0, 0};
#pragma unroll 16
        for (int k = 0; k < 64; ++k) { const f32x4 w = *(const f32x4*)(W + (size_t)k * 6144); const float a = __shfl(sl, k), b = __shfl(sc, k); aL += w * a; aC += w * b; }
        float* mp = (float*)(ws + OFF_MODP) + ((size_t)(l * 16 + ks) * 2) * 6144 + ng * 256 + 4 * lane;
        *(f32x4*)mp = aL; *(f32x4*)(mp + 6144) = aC;
    }
    {
      const f32x4* cs = (const f32x4*)A.in[I_CTX]; f32x4* co = (f32x4*)(ws + OFF_XC);
      for (int i = gt; i < CTX * DM / 4; i += GT) co[i] = cs[i]; }
    for (int i = gt; i < 256 * 8; i += GT) { const int pos = i >> 3, f = i & 7; const float fr = powf(10000.f, -(float)f / 8.f); const float ang = (float)pos * fr;
        float* rp = (float*)(ws + OFF_ROPE) + pos * 16; rp[f] = cosf(ang); rp[8 + f] = sinf(ang); }
    for (int i0 = lt_bid() * NTHREADS; i0 < DEPTH * 2 * 16 * 256; i0 += GT) {
        LAS f32x4* ltab = (LAS f32x4*)lds;
        __syncthreads();
        if (tid < 128) { const int lp = ((i0 >> 8) + (tid >> 6)) * 64 + (tid & 63); const int ldg = lp >> 6;
            const float step = __expf(A.in[I_LSTEP][ldg]);
            const float lr = A.in[I_LRE][lp], li = A.in[I_LIM][lp];
            const float zr = lr * step, zi = li * step, er = expf(zr);
            float sn, cs; sincosf(zi, &sn, &cs);
            const float br = er * cs, bi = er * sn, nr = br - 1.f, ni = bi, den = 1.f / (lr * lr + li * li);
            ltab[tid] = (f32x4){br, bi, (nr * lr + ni * li) * den, (ni * lr - nr * li) * den}; }
        __syncthreads();
        const int i = i0 + tid;
        const int cc = i & 15, c = (i >> 4) & 15, g = (i >> 8) & 15, ld = i >> 12;
        float acc[16];
#pragma unroll
        for (int d = 0; d < 16; ++d) acc[d] = 0.f;
        for (int p = 0; p < 64; ++p) {
            const int lp = (ld * 16 + g) * 64 + p;
            const f32x4 tv = ltab[(tid >> 8) * 64 + p];
            const float br = tv.x, bi = tv.y, qr = tv.z, qi = tv.w;
            const float b_r = A.in[I_BRE][(size_t)lp * 16 + cc], b_i = A.in[I_BIM][(size_t)lp * 16 + cc];
            const float bbr = qr * b_r - qi * b_i, bbi = qr * b_i + qi * b_r;
            const size_t ci = ((size_t)(ld * 16 + g) * 16 + c) * 64 + p;
            const float c_r = A.in[I_CRE][ci], c_i = A.in[I_CIM][ci];
            float wr = c_r * bbr - c_i * bbi, wi = c_r * bbi + c_i * bbr;
#pragma unroll
            for (int d = 0; d < 16; ++d) { acc[d] += wr; const float t = wr * br - wi * bi; wi = wr * bi + wi * br; wr = t; }
        }
        float* kf = (float*)(ws + OFF_KF) + (size_t)(ld * 16 + g) * 4096 + c * 16 + cc;
#pragma unroll
        for (int d = 0; d < 16; ++d) kf[d * 256] = acc[d];
    }
    for (int i = gt; i < DEPTH * 2 * 16 * 64; i += GT) {
        const int g = (i >> 6) & 15, ld = i >> 10;
        const float step = __expf(A.in[I_LSTEP][ld * 16 + g]);
        const float zr = A.in[I_LRE][i] * step * 16.f, zi = A.in[I_LIM][i] * step * 16.f, er = expf(zr);
        float sn, cs; sincosf(zi, &sn, &cs);
        float* lt = (float*)(ws + OFF_LAMT) + (size_t)i * 2; lt[0] = er * cs; lt[1] = er * sn;
    }
    for (int i = gt; i < DEPTH * 2 * 16 * 64 * 17; i += GT) {
        const int e = i % 17, lp = i / 17, g = (lp >> 6) & 15, ld = lp >> 10;
        const float step = __expf(A.in[I_LSTEP][ld * 16 + g]);
        const float lr = A.in[I_LRE][lp], li = A.in[I_LIM][lp];
        const float zr = lr * step, zi = li * step;
        const float pr_ = expf(zr * (float)e); float ps, pc; sincosf(zi * (float)e, &ps, &pc);
        float* pw = (float*)(ws + OFF_POWT) + (size_t)i * 2; pw[0] = pr_ * pc; pw[1] = pr_ * ps;
        if (e == 1) { const float br = pr_ * pc, bi = pr_ * ps, nr = br - 1.f, ni = bi, den = 1.f / (lr * lr + li * li);
            float* qf = (float*)(ws + OFF_QF) + (size_t)lp * 2; qf[0] = (nr * lr + ni * li) * den; qf[1] = (ni * lr - nr * li) * den; }
    }
}

__device__ __forceinline__ void phase_setup2(const PA& A) {
    const int tid = lt_tid();
    const int gt = lt_bid() * NTHREADS + tid, GT = lt_grid() * NTHREADS;
    unsigned char* ws = A.ws;
    for (int i = gt; i < DEPTH * 2 * 6144; i += GT) { const int n = i % 6144, v = (i / 6144) & 1, l = i / 12288;
        float s = A.in[I_BMOD][l * 6144 + n]; const float* mp = (const float*)(ws + OFF_MODP) + ((size_t)(l * 16) * 2 + v) * 6144 + n;
#pragma unroll
        for (int ks = 0; ks < 16; ++ks) s += mp[(size_t)ks * 2 * 6144];
        ((float*)(ws + OFF_MOD))[i] = s; }
    for (int i = gt; i < DEPTH * 16 * 256 * 256; i += GT) {
        const int k = i & 255, n = (i >> 8) & 255, g = (i >> 16) & 15, l = i >> 20;
        const int dir = n >> 7, ri = (n >> 6) & 1, p = n & 63, s = k >> 4, cc = k & 15;
        const int ld = l * 2 + dir, lp = (ld * 16 + g) * 64 + p;
        const float* qf = (const float*)(ws + OFF_QF) + (size_t)lp * 2; const float qr = qf[0], qi = qf[1];
        const float b_r = A.in[I_BRE][(size_t)lp * 16 + cc], b_i = A.in[I_BIM][(size_t)lp * 16 + cc];
        const float bbr = qr * b_r - qi * b_i, bbi = qr * b_i + qi * b_r;
        const int e = dir == 0 ? 15 - s : s;
        const float* pw = (const float*)(ws + OFF_POWT) + ((size_t)lp * 17 + e) * 2; const float pwr = pw[0], pwi = pw[1];
        const float vr = pwr * bbr - pwi * bbi, vi = pwr * bbi + pwi * bbr;
        ((bf16*)(ws + OFF_BTE))[i] = (bf16)f2bf(ri ? vi : vr);
    }
    for (int i = gt; i < DEPTH * 16 * 256 * 512; i += GT) {
        const int k = i & 511, n = (i >> 9) & 255, g = (i >> 17) & 15, l = i >> 21;
        const int t = n >> 4, c = n & 15;
        float v;
        if (k < 256) { const int s = k >> 4, cc = k & 15; v = 0.f;
            const float* kf0 = (const float*)(ws + OFF_KF) + (size_t)((l * 2 + 0) * 16 + g) * 4096 + c * 16 + cc;
            const float* kf1 = (const float*)(ws + OFF_KF) + (size_t)((l * 2 + 1) * 16 + g) * 4096 + c * 16 + cc;
            if (s <= t) v += kf0[(t - s) * 256];
            if (s >= t) v += kf1[(s - t) * 256];
        } else { const int q = k - 256, dir = q >> 7, ri = (q >> 6) & 1, p = q & 63;
            const int ld = l * 2 + dir, lp = (ld * 16 + g) * 64 + p;
            const int e = dir == 0 ? t + 1 : 16 - t;
            const float* pw = (const float*)(ws + OFF_POWT) + ((size_t)lp * 17 + e) * 2; const float pwr = pw[0], pwi = pw[1];
            const size_t ci = ((size_t)(ld * 16 + g) * 16 + c) * 64 + p;
            const float c_r = A.in[I_CRE][ci], c_i = A.in[I_CIM][ci];
            v = ri ? -(c_r * pwi + c_i * pwr) : (c_r * pwr - c_i * pwi);
        }
        ((bf16*)(ws + OFF_BTY))[i] = (bf16)f2bf(v);
    }
}

__device__ __forceinline__ void phase_modnorm(const PA& A, int layer, int which) {
    const int tid = lt_tid(), lane = tid & 63, wave = tid >> 6;
    const int gw = lt_bid() * 8 + wave, NGW = lt_grid() * 8;
    unsigned char* ws = A.ws;
    const float* g = A.in[which ? I_NORM2 : I_NORM1] + layer * DM;
    const int shi = which ? 3 : 0, sci = which ? 4 : 1;
    bf16* H = (bf16*)(ws + OFF_H);
#pragma unroll 1
    for (int v = 0; v < 2; ++v) {
        const float* mod = (const float*)(ws + OFF_MOD) + (size_t)(layer * 2 + v) * 6144;
        f32x4 a[4], b[4];
#pragma unroll
        for (int j = 0; j < 4; ++j) { const int col = 4 * lane + 256 * j; const f32x4 gv = *(const f32x4*)(g + col), sc = *(const f32x4*)(mod + sci * DM + col);
            a[j] = gv * (sc + 1.0f); b[j] = *(const f32x4*)(mod + shi * DM + col); }
        const int m0 = v ? 0 : CTX, m1 = v ? CTX : MR;
        for (int m = m0 + gw; m < m1; m += 2 * NGW) {
            const int mb = m + NGW < m1 ? m + NGW : m;
            const bool first = (layer == 0 && which == 0);
            const float* xlat = first ? A.in[I_X] : (const float*)A.out;
            const float* xr0 = (m < CTX) ? (const float*)(ws + OFF_XC) + (size_t)m * DM : xlat + (size_t)(m - CTX) * DM;
            const float* xr1 = (mb < CTX) ? (const float*)(ws + OFF_XC) + (size_t)mb * DM : xlat + (size_t)(mb - CTX) * DM;
            f32x4 x[4], y[4]; float s0 = 0.f, s1 = 0.f;
#pragma unroll
            for (int j = 0; j < 4; ++j) { x[j] = *(const f32x4*)(xr0 + 4 * lane + 256 * j); y[j] = *(const f32x4*)(xr1 + 4 * lane + 256 * j); }
#pragma unroll
            for (int j = 0; j < 4; ++j) { s0 += (x[j].x * x[j].x + x[j].y * x[j].y) + (x[j].z * x[j].z + x[j].w * x[j].w); s1 += (y[j].x * y[j].x + y[j].y * y[j].y) + (y[j].z * y[j].z + y[j].w * y[j].w); }
#pragma unroll
            for (int o = 1; o < 64; o <<= 1) { s0 += __shfl_xor(s0, o); s1 += __shfl_xor(s1, o); }
            const float r0 = rsqrtf(s0 * (1.f / DM) + EPS), r1 = rsqrtf(s1 * (1.f / DM) + EPS);
            if (first && m >= CTX) {
#pragma unroll
                for (int j = 0; j < 4; ++j) { *(f32x4*)(A.out + (size_t)(m - CTX) * DM + 4 * lane + 256 * j) = x[j]; if (mb != m) *(f32x4*)(A.out + (size_t)(mb - CTX) * DM + 4 * lane + 256 * j) = y[j]; } }
#pragma unroll
            for (int j = 0; j < 4; ++j) { const f32x4 o = x[j] * r0 * a[j] + b[j]; u32x2 w; w.x = cvtpk(o.x, o.y); w.y = cvtpk(o.z, o.w);
                st8_wt(H + (size_t)m * DM + 4 * lane + 256 * j, w); }
            if (mb != m) {
#pragma unroll
                for (int j = 0; j < 4; ++j) { const f32x4 o = y[j] * r1 * a[j] + b[j]; u32x2 w; w.x = cvtpk(o.x, o.y); w.y = cvtpk(o.z, o.w);
                    st8_wt(H + (size_t)mb * DM + 4 * lane + 256 * j, w); } }
        }
    }
}
#define RLX_AGENT __ATOMIC_RELAXED, __HIP_MEMORY_SCOPE_AGENT
#define XB_TMO      128
#define XB_XCNT(j)  (256  + 64 * (j))
#define XB_XSUB(j)  (1280 + 64 * (j))
#define XB_XGEN(j)  (2304 + 64 * (j))
#define XB_TOP      3328
#define XB_TOPGEN   3392
#define XCD_BAR_WORDS 3456
#define XB_SPIN_CAP (1u << 18)

__device__ __forceinline__ unsigned xb_ld(unsigned* p)              { return __hip_atomic_load(p, __ATOMIC_RELAXED, __HIP_MEMORY_SCOPE_AGENT); }
__device__ __forceinline__ unsigned xb_add(unsigned* p, unsigned v) { return __hip_atomic_fetch_add(p, v, __ATOMIC_RELAXED, __HIP_MEMORY_SCOPE_AGENT); }
__device__ __forceinline__ unsigned xb_xcc_id() { return (unsigned)__builtin_amdgcn_s_getreg((3 << 11) | 20) & 0xFu; }
#define XB_SPIN(cond, bar) do { unsigned _sp = 0; while (cond) { __builtin_amdgcn_s_sleep(1); \
    if ((++_sp & 255u) == 0u) { if (xb_ld(&(bar)[XB_TMO])) break; if (_sp > XB_SPIN_CAP) { atomicAdd(&(bar)[XB_TMO], 1u); break; } } } } while (0)

struct XcdBarrier {
    unsigned* bar; unsigned x;
    volatile LAS unsigned* st;
};

__device__ __forceinline__ XcdBarrier xcd_barrier_post(unsigned* bar, volatile LAS unsigned* st) {
    XcdBarrier b; b.bar = bar; b.x = xb_xcc_id(); b.st = st;
    if (threadIdx.x == 0) (void)xb_add(&bar[XB_XCNT(b.x)], 1u);
    return b;
}
__device__ __forceinline__ void xcd_barrier_complete(unsigned* bar, unsigned x, unsigned& nloc, unsigned& nx) {
    const unsigned G = gridDim.x * gridDim.y * gridDim.z;
    unsigned sum, cnt, mine, sp = 0u;
    for (;;) {
        sum = 0u; cnt = 0u; mine = 0u;
#pragma unroll
        for (unsigned j = 0; j < 16; ++j) { const unsigned c = xb_ld(&bar[XB_XCNT(j)]); sum += c; cnt += (c > 0u) ? 1u : 0u; mine = (j == x) ? c : mine; }
        if (sum == G) break;
        __builtin_amdgcn_s_sleep(1);
        if ((++sp & 255u) == 0u) { if (xb_ld(&bar[XB_TMO])) break; if (sp > XB_SPIN_CAP) { atomicAdd(&bar[XB_TMO], 1u); break; } }
    }
    nloc = mine > 0u ? mine : 1u; nx = cnt > 0u ? cnt : 1u;
}

__device__ __forceinline__ void xcd_barrier(const XcdBarrier& b) {
    asm volatile("s_waitcnt vmcnt(0)" ::: "memory");
    __syncthreads();
    if (threadIdx.x == 0) {
        unsigned* bar = b.bar;
        __builtin_amdgcn_s_waitcnt(0);
        unsigned nloc = b.st[0], nx = b.st[1];
        if (nloc == 0u) { xcd_barrier_complete(bar, b.x, nloc, nx); b.st[0] = nloc; b.st[1] = nx; }
        const unsigned old = xb_add(&bar[XB_XSUB(b.x)], 1u);
        const unsigned gen = old / nloc;
        if (old + 1u == (gen + 1u) * nloc) {
            __builtin_amdgcn_fence(__ATOMIC_RELEASE, "agent");
            asm volatile("s_waitcnt vmcnt(0)" ::: "memory");
            const unsigned og = xb_add(&bar[XB_TOP], 1u);
            const unsigned tg = og / nx;
            if (og + 1u == (tg + 1u) * nx) xb_add(&bar[XB_TOPGEN], 1u);
            else XB_SPIN(xb_ld(&bar[XB_TOPGEN]) == tg, bar);
            __builtin_amdgcn_fence(__ATOMIC_ACQUIRE, "agent");
            xb_add(&bar[XB_XGEN(b.x)], 1u);
            asm volatile("s_waitcnt vmcnt(0)" ::: "memory");
        } else {
            XB_SPIN(xb_ld(&bar[XB_XGEN(b.x)]) == gen, bar);
            __builtin_amdgcn_fence(__ATOMIC_ACQUIRE, "agent");
            asm volatile("s_waitcnt vmcnt(0)" ::: "memory");
        }
    }
    __syncthreads();
}

constexpr float QSCALE = 0.17677669529663687f * 1.4426950408889634f;
struct EpiIn {
    static constexpr bool PERM = true, AFTER_DRAIN = false;
    bf16 *ZB, *XBC, *UB, *QB, *KB, *VB; float* DTB; const float *qn, *kn, *dtbias, *rope;
    __device__ __forceinline__ void operator()(const f32x4 (&acc)[2][2][4][2], const pg8::Unit& u, int wr, int wc, int fr, int fq) const {
        const int pn = u.pn; int row0 = u.pm * 256 + wr * 64 + fr; asm volatile("" : "+v"(row0));
        if (pn <= 3 || pn == 8 || pn == 9) {
            bf16* base; int ld, c0;
            if (pn == 0) { base = ZB; ld = 256; c0 = 0; } else if (pn <= 2) { base = XBC; ld = 512; c0 = (pn - 1) * 256; } else if (pn == 3) { base = UB; ld = 256; c0 = 0; } else { base = VB; ld = 512; c0 = (pn - 8) * 256; }
#pragma unroll
            for (int ai = 0; ai < 2; ++ai)
#pragma unroll
                for (int m = 0; m < 4; ++m) { const int row = row0 + ai * 128 + m * 16;
#pragma unroll
                    for (int bj = 0; bj < 2; ++bj) { f32x4 v0 = acc[ai][bj][m][0], v1 = acc[ai][bj][m][1];
                        if (pn == 0) {
#pragma unroll
                            for (int e = 0; e < 4; ++e) { v0[e] = siluf(v0[e]); v1[e] = siluf(v1[e]); } }
                        u32x4 w; w.x = cvtpk(v0[0], v0[1]); w.y = cvtpk(v0[2], v0[3]); w.z = cvtpk(v1[0], v1[1]); w.w = cvtpk(v1[2], v1[3]);
                        st16_wt(base + (size_t)row * ld + c0 + bj * 128 + wc * 32 + 8 * fq, w); } }
        } else if (pn <= 7) {
            const bool isq = pn <= 5; bf16* base = isq ? QB : KB; const float* nw = isq ? qn : kn; const int c0 = ((pn - 4) & 1) * 256;
            const f32x4 w0 = *(const f32x4*)(nw + 8 * fq), w1 = *(const f32x4*)(nw + 8 * fq + 4);
            const float sgn = (fq & 1) ? 1.f : -1.f;
#pragma unroll
            for (int ai = 0; ai < 2; ++ai)
#pragma unroll
                for (int m = 0; m < 4; ++m) { const int row = row0 + ai * 128 + m * 16; const int t = row - CTX;
                    f32x4 cs0 = {1, 1, 1, 1}, cs1 = {1, 1, 1, 1}, sn0 = {0, 0, 0, 0}, sn1 = {0, 0, 0, 0};
                    if (row >= CTX) { const int pos = (fq < 2) ? (t >> 6) : (t & 63); const float* rp = rope + pos * 16;
                        cs0 = *(const f32x4*)rp; cs1 = *(const f32x4*)(rp + 4); sn0 = *(const f32x4*)(rp + 8); sn1 = *(const f32x4*)(rp + 12); }
#pragma unroll
                    for (int bj = 0; bj < 2; ++bj) { f32x4 v0 = acc[ai][bj][m][0], v1 = acc[ai][bj][m][1];
                        float ss = (v0[0] * v0[0] + v0[1] * v0[1]) + (v0[2] * v0[2] + v0[3] * v0[3]) + (v1[0] * v1[0] + v1[1] * v1[1]) + (v1[2] * v1[2] + v1[3] * v1[3]);
                        ss += __shfl_xor(ss, 16); ss += __shfl_xor(ss, 32);
                        const float r = rsqrtf(ss * (1.f / 32.f) + EPS);
                        v0 = v0 * r * w0; v1 = v1 * r * w1;
                        f32x4 p0, p1;
#pragma unroll
                        for (int e = 0; e < 4; ++e) { p0[e] = __shfl_xor(v0[e], 16); p1[e] = __shfl_xor(v1[e], 16); }
                        v0 = v0 * cs0 + p0 * sn0 * sgn; v1 = v1 * cs1 + p1 * sn1 * sgn;
                        if (isq) { v0 = v0 * QSCALE; v1 = v1 * QSCALE; }
                        u32x4 w; w.x = cvtpk(v0[0], v0[1]); w.y = cvtpk(v0[2], v0[3]); w.z = cvtpk(v1[0], v1[1]); w.w = cvtpk(v1[2], v1[3]);
                        st16_wt(base + (size_t)row * 512 + c0 + bj * 128 + wc * 32 + 8 * fq, w); } }
        } else {
            if (wc == 0 && fq == 0) {
                const f32x4 b0 = *(const f32x4*)dtbias, b1 = *(const f32x4*)(dtbias + 4);
#pragma unroll
                for (int ai = 0; ai < 2; ++ai)
#pragma unroll
                    for (int m = 0; m < 4; ++m) { const int row = row0 + ai * 128 + m * 16; f32x4 v0 = acc[ai][0][m][0] + b0, v1 = acc[ai][0][m][1] + b1;
#pragma unroll
                        for (int e = 0; e < 4; ++e) { v0[e] = v0[e] > 20.f ? v0[e] : __logf(1.f + __expf(v0[e])); v1[e] = v1[e] > 20.f ? v1[e] : __logf(1.f + __expf(v1[e])); }
                        *(f32x4*)(DTB + (size_t)row * 8) = v0; *(f32x4*)(DTB + (size_t)row * 8 + 4) = v1; }
            }
        }
    }
};
struct SplitOrder {
    pg8::StaticOrder S0; int G, c, nkt_full, nsplit, with_ctx, r0;
    __device__ __forceinline__ void init(int G_, int c_, int nkt_, int nsplit_, bool ctx_) { S0.init(SEQ, DM, G_, c_); S0.nkt = nkt_; G = G_; c = c_; nkt_full = nkt_; nsplit = nsplit_; with_ctx = ctx_ ? 1 : 0; r0 = (256 + G_ - 1) / G_; }
    __device__ __forceinline__ bool next(int i, pg8::Unit& u) const {
        const bool own_ctx = with_ctx && G >= 256 && c < 4 * nsplit;
        if (own_ctx) { if (i == 0) { u.pm = 0; u.pn = c & 3; u.k0 = (c >> 2) * 256; u.nkt = 4; return true; } i -= 1; }
        if (i < r0) { if (S0.next(i, u)) { u.pm += 1; return true; } }
        if (!with_ctx || G >= 256) return false;
        const int j = (i - r0) * G + c;
        if (i < r0 || j >= 4 * nsplit) return false;
        u.pm = 0; u.pn = j & 3; u.k0 = (j >> 2) * 256; u.nkt = 4; return true;
    }
    __device__ __forceinline__ void a_ready(const pg8::Unit&) const {}
    __device__ __forceinline__ void done(const pg8::Unit&) const {}
};
struct EpiRes {
    static constexpr bool PERM = true, AFTER_DRAIN = false;
    float* outx; float* xc; const float* gate_l; const float* gate_c; float gscale;
    __device__ __forceinline__ void operator()(const f32x4 (&acc)[2][2][4][2], const pg8::Unit& u, int wr, int wc, int fr, int fq) const {
        int fq2 = fq; asm volatile("" : "+v"(fq2));
        int row0 = u.pm * 256 + wr * 64 + fr; asm volatile("" : "+v"(row0));
#pragma unroll
        for (int ai = 0; ai < 2; ++ai)
#pragma unroll
            for (int m = 0; m < 4; ++m) { const int row = row0 + ai * 128 + m * 16;
                float* xr = row < CTX ? xc + (size_t)row * DM : outx + (size_t)(row - CTX) * DM; const float* gt = row < CTX ? gate_c : gate_l;
#pragma unroll
                for (int bj = 0; bj < 2; ++bj) { const int col = u.pn * 256 + bj * 128 + wc * 32 + 8 * fq2;
#pragma unroll
                    for (int n = 0; n < 2; ++n) { const f32x4 g = *(const f32x4*)(gt + col + 4 * n) * gscale;
                        if (u.pm == 0) { const f32x4 v = g * acc[ai][bj][m][n];
#pragma unroll
                            for (int e = 0; e < 4; ++e) (void)__hip_atomic_fetch_add(xr + col + 4 * n + e, v[e], __ATOMIC_RELAXED, __HIP_MEMORY_SCOPE_AGENT); }
                        else { f32x4 x = *(const f32x4*)(xr + col + 4 * n); x += g * acc[ai][bj][m][n]; st16_wt(xr + col + 4 * n, __builtin_bit_cast(u32x4, x)); } } }
                asm volatile("" ::: "memory"); }
    }
};
struct EpiFfn {
    static constexpr bool PERM = true, AFTER_DRAIN = false;
    bf16* FFU;
    __device__ __forceinline__ void operator()(const f32x4 (&acc)[2][2][4][2], const pg8::Unit& u, int wr, int wc, int fr, int fq) const {
        int row0 = u.pm * 256 + wr * 64 + fr; asm volatile("" : "+v"(row0));
#pragma unroll
        for (int ai = 0; ai < 2; ++ai)
#pragma unroll
            for (int m = 0; m < 4; ++m) { const int row = row0 + ai * 128 + m * 16;
                f32x4 v0 = acc[ai][0][m][0], v1 = acc[ai][0][m][1]; const f32x4 g0 = acc[ai][1][m][0], g1 = acc[ai][1][m][1];
#pragma unroll
                for (int e = 0; e < 4; ++e) { v0[e] = siluf(v0[e]) * g0[e]; v1[e] = siluf(v1[e]) * g1[e]; }
                u32x4 w; w.x = cvtpk(v0[0], v0[1]); w.y = cvtpk(v0[2], v0[3]); w.z = cvtpk(v1[0], v1[1]); w.w = cvtpk(v1[2], v1[3]);
                st16_wt(FFU + (size_t)row * DFF + u.pn * 128 + wc * 32 + 8 * fq, w); }
    }
};
struct EpiGlu {
    static constexpr bool PERM = true, AFTER_DRAIN = false;
    const bf16* YG; bf16* MIX; const float* gb;
    __device__ __forceinline__ void operator()(const f32x4 (&acc)[2][2][4][2], const pg8::Unit& u, int wr, int wc, int fr, int fq) const {
        int fq2 = fq; asm volatile("" : "+v"(fq2));
        int row0 = u.pm * 256 + wr * 64 + fr; asm volatile("" : "+v"(row0));
#pragma unroll
        for (int ai = 0; ai < 2; ++ai)
#pragma unroll
            for (int m = 0; m < 4; ++m) { const int row = row0 + ai * 128 + m * 16;
#pragma unroll
                for (int bj = 0; bj < 2; ++bj) { const int col = bj * 128 + wc * 32 + 8 * fq2;
                    const u32x4 yv = *(const u32x4*)(YG + (size_t)row * 256 + col);
                    const f32x4 b0 = *(const f32x4*)(gb + col), b1 = *(const f32x4*)(gb + col + 4);
                    f32x4 v0 = acc[ai][bj][m][0] + b0, v1 = acc[ai][bj][m][1] + b1;
                    float y[8]; y[0] = bf2f(yv.x & 0xffff); y[1] = bf2f(yv.x >> 16); y[2] = bf2f(yv.y & 0xffff); y[3] = bf2f(yv.y >> 16);
                    y[4] = bf2f(yv.z & 0xffff); y[5] = bf2f(yv.z >> 16); y[6] = bf2f(yv.w & 0xffff); y[7] = bf2f(yv.w >> 16);
#pragma unroll
                    for (int e = 0; e < 4; ++e) { v0[e] = y[e] * sigmf(v0[e]); v1[e] = y[4 + e] * sigmf(v1[e]); }
                    u32x4 w; w.x = cvtpk(v0[0], v0[1]); w.y = cvtpk(v0[2], v0[3]); w.z = cvtpk(v1[0], v1[1]); w.w = cvtpk(v1[2], v1[3]);
                    *(u32x4*)(MIX + (size_t)row * DM + 256 + col) = w; }
                asm volatile("" ::: "memory"); }
    }
};

constexpr int AKS = 144;
constexpr int ASTB = 128 * AKS;
#ifndef VKS_BYTES
#define VKS_BYTES 192
#endif
constexpr int VKS = VKS_BYTES;
constexpr int VSTB = 128 * VKS;
constexpr int VBASE = 3 * ASTB;
static_assert(VBASE + 3 * VSTB <= 131072, "attention LDS");
#ifndef EXP_POLY_MASK
#define EXP_POLY_MASK 0
#endif
__device__ __forceinline__ float exp2_poly(float x) {
    const float M = 12582912.f;
    const float t = x + M;
    const float f = x - (t - M);
    const float p = __builtin_fmaf(__builtin_fmaf(__builtin_fmaf(0.0551716685f, f, 0.2426111251f), f, 0.6932609677f), f, 0.9999280572f);
    return __builtin_bit_cast(float, __builtin_bit_cast(int, p) + (__builtin_bit_cast(int, t) << 23));
}
__device__ __forceinline__ void attn_qk(f32x16 (&st)[2], const LAS unsigned char* Kb, int half, const bf16x8 (&qf)[2][2], int r, int hi) {
#pragma unroll
    for (int c = 0; c < 2; ++c) {
        const LAS unsigned char* kp = Kb + (32 * half + r) * AKS + c * 64 + hi * 16;
        const bf16x8 a0 = *(const LAS bf16x8*)kp, a1 = *(const LAS bf16x8*)(kp + 32);
        f32x16 z;
#pragma unroll
        for (int i = 0; i < 16; ++i) z[i] = 0.f;
        z = MFMA32(a0, qf[c][0], z); st[c] = MFMA32(a1, qf[c][1], z);
    }
}
#ifndef ATT_NOPF
#define ATT_NOPF 0
#endif
#ifndef ATT_PACKORDER
#define ATT_PACKORDER 0
#endif
#ifndef ATT_VSUM
#define ATT_VSUM 0
#endif
#ifndef ATT_SB
#define ATT_SB 0
#endif
#if ATT_SB
#define ATT_SBAR() __builtin_amdgcn_sched_barrier(0)
#else
#define ATT_SBAR() do {} while (0)
#endif
__device__ __forceinline__ void attn_half(f32x16 (&cur)[2], f32x16 (&nxt)[2], const LAS unsigned char* Knext, bool has_next, const LAS unsigned char* Vh, f32x16 (&O)[2][2], f32x4 (&ls4)[2], const bf16x8 aones,
                                          const bf16x8 (&qf)[2][2], int r, int hi, int vrd) {
#ifndef ATT_IGLP
#define ATT_IGLP 3
#endif
#if ATT_IGLP >= 0
    __builtin_amdgcn_iglp_opt(ATT_IGLP);
#endif
    bf16x8 kf[2][2], vf[2][2];
#if ATT_NOPF
    const LAS unsigned char* kp = Knext + r * AKS + hi * 16;
#else
    const LAS unsigned char* kp = Knext + r * AKS + hi * 16;
#endif
#pragma unroll
    for (int c = 0; c < 2; ++c) { kf[c][0] = *(const LAS bf16x8*)(kp + c * 64); kf[c][1] = *(const LAS bf16x8*)(kp + c * 64 + 32); }
#pragma unroll
    for (int sp = 0; sp < 2; ++sp)
#pragma unroll
        for (int vt = 0; vt < 2; ++vt) { const LAS unsigned char* vp = Vh + (16 * sp) * VKS + (32 * vt) * 2 + vrd; vf[sp][vt] = cat8(vtr(vp), vtr(vp + 8 * VKS)); }
#pragma unroll
    for (int c = 0; c < 2; ++c) { f32x16 z;
#pragma unroll
        for (int i = 0; i < 16; ++i) z[i] = 0.f;
        z = MFMA32(kf[c][0], qf[c][0], z);
#if ATT_NOPF
        cur[c] = MFMA32(kf[c][1], qf[c][1], z); }
#else
        nxt[c] = MFMA32(kf[c][1], qf[c][1], z); }
#endif
#if ATT_PACKORDER
#pragma unroll
    for (int sp = 0; sp < 2; ++sp)
#pragma unroll
        for (int c = 0; c < 2; ++c) {
#pragma unroll
            for (int i = 8 * sp; i < 8 * sp + 8; ++i) cur[c][i] = __builtin_amdgcn_exp2f(cur[c][i]);
            const bf16x8 pk = pack8(cur[c], sp);
            ls4[c] = MFMA16(aones, pk, ls4[c]);
            O[c][0] = MFMA32(vf[sp][0], pk, O[c][0]);
            O[c][1] = MFMA32(vf[sp][1], pk, O[c][1]);
        }
#else
    bf16x8 pb[2][2];
#ifdef PROBE_EXP2X
    float zprobe = 0.f; asm volatile("" : "+v"(zprobe));
#endif
#pragma unroll
    for (int c = 0; c < 2; ++c) {
#pragma unroll
        for (int i = 0; i < 16; ++i) {
#ifdef PROBE_EXP2X
            const float e1 = __builtin_amdgcn_exp2f(cur[c][i]), e2 = __builtin_amdgcn_exp2f(cur[c][i] + zprobe); cur[c][i] = 0.5f * (e1 + e2);
#else
            cur[c][i] = ((EXP_POLY_MASK >> i) & 1) ? exp2_poly(cur[c][i]) : __builtin_amdgcn_exp2f(cur[c][i]);
#endif
        }
    }
#pragma unroll
    for (int c = 0; c < 2; ++c) {
        pb[c][0] = pack8(cur[c], 0); pb[c][1] = pack8(cur[c], 1);
#if ATT_VSUM
        { float s0 = 0.f, s1 = 0.f;
#pragma unroll
          for (int i = 0; i < 16; i += 2) { s0 += cur[c][i]; s1 += cur[c][i + 1]; }
          ls4[c][0] += s0 + s1; }
#else
        ls4[c] = MFMA16(aones, pb[c][0], ls4[c]); ls4[c] = MFMA16(aones, pb[c][1], ls4[c]);
#endif
    }
#if ATT_VSUM
    asm volatile("" : "+v"(ls4[0][0]), "+v"(ls4[1][0]));
#endif
#pragma unroll
    for (int sp = 0; sp < 2; ++sp)
#pragma unroll
        for (int vt = 0; vt < 2; ++vt) {
            O[0][vt] = MFMA32(vf[sp][vt], pb[0][sp], O[0][vt]);
            O[1][vt] = MFMA32(vf[sp][vt], pb[1][sp], O[1][vt]);
        }
#endif
#ifndef ATT_SGB
#define ATT_SGB 0
#endif
#if ATT_SGB == 2
    __builtin_amdgcn_sched_group_barrier(0x100, 4, 0);
#pragma unroll
    for (int k = 0; k < 16; ++k) { __builtin_amdgcn_sched_group_barrier(0x008, 1, 0); __builtin_amdgcn_sched_group_barrier(0x400, 2, 0); __builtin_amdgcn_sched_group_barrier(0x100, 1, 0); __builtin_amdgcn_sched_group_barrier(0x002, 1, 0); }
#elif ATT_SGB
    __builtin_amdgcn_sched_group_barrier(0x100, 12, 0);
#pragma unroll
    for (int k = 0; k < 4; ++k) { __builtin_amdgcn_sched_group_barrier(0x008, 1, 0); __builtin_amdgcn_sched_group_barrier(0x002, 8, 0); }
#pragma unroll
    for (int k = 0; k < 12; ++k) { __builtin_amdgcn_sched_group_barrier(0x008, 1, 0); __builtin_amdgcn_sched_group_barrier(0x002, 2, 0); }
#endif
}
__device__ __forceinline__ void phase_attn(const PA& A, int layer, LAS unsigned char* lds) {
    const int tid = lt_tid(), lane = tid & 63, r = lane & 31, hi = lane >> 5;
    const int wid = __builtin_amdgcn_readfirstlane(tid >> 6);
    const int i16 = lane & 15, q4 = i16 >> 2, p4 = i16 & 3, blk = (lane >> 4) & 1;
    unsigned char* ws = A.ws;
    const bf16* QB = (const bf16*)(ws + OFF_QB); const bf16* KB = (const bf16*)(ws + OFF_KB); const bf16* VB = (const bf16*)(ws + OFF_VB);
    bf16* MIX = (bf16*)(ws + OFF_MIX);
    const float lam_init = 0.8f - 0.6f * __expf(-0.3f * (float)layer);
    float lamv;
    { const float* lv = A.in[I_DALAM] + layer * 128; float a = (lane < 32) ? lv[lane] * lv[32 + lane] : 0.f, b = (lane < 32) ? lv[64 + lane] * lv[96 + lane] : 0.f;
      a = wave_sum(a); b = wave_sum(b); lamv = __expf(a) - __expf(b) + lam_init; }
    const float post = 1.f - lam_init;
    const float* subn = A.in[I_SUBN] + layer * 64;
    const int skey = tid >> 3, spc = tid & 7;
    const unsigned soff = skey * AKS + spc * 16;
    const unsigned svoff = skey * VKS + spc * 16;
    const int vrd = (4 * hi + q4) * VKS + (16 * blk) * 2 + 8 * p4;
    bf16x8 aones; { const short one = ((((lane & 15) >> 3) & 1) == ((lane >> 4) & 1)) ? (short)0x3F80 : (short)0;
#pragma unroll
        for (int j = 0; j < 8; ++j) aones[j] = one; }
    const int abid = lt_bid(), agrid = lt_grid();
    const int n_lat = (512 - abid + agrid - 1) / agrid;
    const int n_units = n_lat + ((abid >= 128 && abid < 136) ? 1 : 0);
#ifndef ATT_PRIO
#define ATT_PRIO 0
#endif
#if ATT_PRIO
    if (wid >= 4) __builtin_amdgcn_s_setprio(2);
#endif
    for (int ui = 0; ui < n_units; ++ui) {
        const int u = ui < n_lat ? abid + ui * agrid : 512 + (abid - 128);
        const int h = u & 7, qb = u >> 3;
        const int qrow0 = qb < 64 ? CTX + qb * 256 : 0; const int nst = qb < 64 ? MR / 128 : CTX / 128;
        const bf16* qp = QB + (size_t)(qrow0 + wid * 32 + r) * 512 + h * 64 + hi * 8;
        bf16x8 qf[2][2];
#pragma unroll
        for (int c = 0; c < 2; ++c)
#pragma unroll
            for (int s = 0; s < 2; ++s) qf[c][s] = *(const bf16x8*)(qp + c * 32 + s * 16);
        const bf16* kg = KB + (size_t)skey * 512 + h * 64 + spc * 8; const bf16* vg = VB + (size_t)skey * 512 + h * 64 + spc * 8;
        u32x4 kr0 = *(const u32x4*)kg, kr1 = *(const u32x4*)(kg + 64 * 512), vr0 = *(const u32x4*)vg, vr1 = *(const u32x4*)(vg + 64 * 512);
        __syncthreads();
        *(LAS u32x4*)(lds + soff) = kr0; *(LAS u32x4*)(lds + 64 * AKS + soff) = kr1;
        *(LAS u32x4*)(lds + VBASE + svoff) = vr0; *(LAS u32x4*)(lds + VBASE + 64 * VKS + svoff) = vr1;
        { kr0 = *(const u32x4*)(kg + (size_t)128 * 512); kr1 = *(const u32x4*)(kg + (size_t)192 * 512); vr0 = *(const u32x4*)(vg + (size_t)128 * 512); vr1 = *(const u32x4*)(vg + (size_t)192 * 512); }
        __syncthreads();
        f32x16 O[2][2];
#pragma unroll
        for (int c = 0; c < 2; ++c)
#pragma unroll
            for (int vt = 0; vt < 2; ++vt)
#pragma unroll
                for (int i = 0; i < 16; ++i) O[c][vt][i] = 0.f;
        f32x4 ls4[2] = {{0.f, 0.f, 0.f, 0.f}, {0.f, 0.f, 0.f, 0.f}};
        f32x16 sa[2], sb[2];
        attn_qk(sa, lds, 0, qf, r, hi);
        int bcur = 0;
#pragma unroll 2
        for (int s = 0; s < nst; ++s) {
            const int bnext = bcur == 2 ? 0 : bcur + 1;
            const LAS unsigned char* Kc = lds + bcur * ASTB; const LAS unsigned char* Vc = lds + VBASE + bcur * VSTB;
            const LAS unsigned char* Kn = lds + bnext * ASTB;
            *(LAS u32x4*)(lds + bnext * ASTB + soff) = kr0; *(LAS u32x4*)(lds + bnext * ASTB + 64 * AKS + soff) = kr1;
            *(LAS u32x4*)(lds + VBASE + bnext * VSTB + svoff) = vr0; *(LAS u32x4*)(lds + VBASE + bnext * VSTB + 64 * VKS + svoff) = vr1;
            { const int s2 = s + 2 < nst ? s + 2 : nst - 1; const size_t go = (size_t)s2 * 128 * 512; kr0 = *(const u32x4*)(kg + go); kr1 = *(const u32x4*)(kg + go + 64 * 512); vr0 = *(const u32x4*)(vg + go); vr1 = *(const u32x4*)(vg + go + 64 * 512); }
            ATT_SBAR();
            attn_half(sa, sb, Kc + 32 * AKS, true, Vc, O, ls4, aones, qf, r, hi, vrd);
            ATT_SBAR();
            attn_half(sb, sa, Kc + 64 * AKS, true, Vc + 32 * VKS, O, ls4, aones, qf, r, hi, vrd);
            ATT_SBAR();
            attn_half(sa, sb, Kc + 96 * AKS, true, Vc + 64 * VKS, O, ls4, aones, qf, r, hi, vrd);
            ATT_SBAR();
            asm volatile("s_waitcnt lgkmcnt(0)\n\ts_barrier" ::: "memory");
            attn_half(sb, sa, Kn, true, Vc + 96 * VKS, O, ls4, aones, qf, r, hi, vrd);
            ATT_SBAR();
            bcur = bnext;
        }
#if ATT_VSUM
        const float l0 = ls4[0][0] + __shfl_xor(ls4[0][0], 32), l1 = ls4[1][0] + __shfl_xor(ls4[1][0], 32);
#else
        const int lsrc = r < 16 ? r : r + 16;
        const float l0 = __shfl(ls4[0][0], lsrc), l1 = __shfl(ls4[1][0], lsrc);
#endif
        const float inv0 = 1.f / l0, inv1 = lamv / l1;
        float ss = 0.f;
#pragma unroll
        for (int vt = 0; vt < 2; ++vt)
#pragma unroll
            for (int i = 0; i < 16; ++i) { const float o = O[0][vt][i] * inv0 - O[1][vt][i] * inv1; O[0][vt][i] = o; ss += o * o; }
        ss += __shfl_xor(ss, 32);
        const float rn = rsqrtf(ss * (1.f / 64.f) + EPS) * post;
        const int row = qrow0 + wid * 32 + r;
#pragma unroll
        for (int vt = 0; vt < 2; ++vt)
#pragma unroll
            for (int g4 = 0; g4 < 4; ++g4) { const int v0 = 32 * vt + 8 * g4 + 4 * hi; const f32x4 sw = *(const f32x4*)(subn + v0);
                u32x2 w; w.x = cvtpk(O[0][vt][4 * g4] * rn * sw[0], O[0][vt][4 * g4 + 1] * rn * sw[1]); w.y = cvtpk(O[0][vt][4 * g4 + 2] * rn * sw[2], O[0][vt][4 * g4 + 3] * rn * sw[3]);
                *(u32x2*)(MIX + (size_t)row * DM + 512 + h * 64 + v0) = w; }
    }
#if ATT_PRIO
    __builtin_amdgcn_s_setprio(0);
#endif
}

constexpr int XST = 528, BST = 272;
constexpr int L_X0 = 0, L_X1 = 64 * XST, L_B = 2 * 64 * XST, L_C = L_B + 64 * BST, L_SC = L_C + 64 * BST;
constexpr int L_DT = L_SC + 2048, L_WT = L_DT + 2048, L_SSQ = L_WT + 2048, L_SSD_END = L_SSQ + 1024;
static_assert(L_SSD_END <= 131072, "ssd lds");

__device__ __forceinline__ float ssd_scan_dt(const PA& A, int layer, int ch, LAS unsigned char* lds, int w, int lane) {
    const float* DTB = (const float*)(A.ws + OFF_DTB);
    const float dt = DTB[(size_t)(ch * 64 + lane) * 8 + w];
    const float a = -__expf(A.in[I_ALOG][layer * 8 + w]);
    const float v = dt * a; float x = v;
#pragma unroll
    for (int o = 1; o < 64; o <<= 1) { const float y = __shfl_up(x, o); if (lane >= o) x += y; }
    const float total = __shfl(x, 63);
    LAS float* SC = (LAS float*)(lds + L_SC); LAS float* DT = (LAS float*)(lds + L_DT); LAS float* WT = (LAS float*)(lds + L_WT);
    DT[w * 64 + lane] = dt;
    if (w < 4) { SC[w * 64 + lane] = x; WT[w * 64 + lane] = dt * __expf(total - x); }
    else { SC[w * 64 + lane] = total - x + v; WT[w * 64 + lane] = dt * __expf(x - v); }
    return __expf(total);
}

template <int MODE> __device__ __forceinline__ void ssd_conv(const PA& A, int layer, int ch, LAS unsigned char* lds, int tid) {
    const bf16* XBC = (const bf16*)(A.ws + OFF_XBC);
    const int c = tid;
    bf16* XACT = (bf16*)(A.ws + OFF_XACT);
    const float* cw = A.in[I_CONVW] + layer * 3 * 512; const float w0 = cw[c], w1 = cw[512 + c], w2 = cw[1024 + c], b = A.in[I_CONVB][layer * 512 + c];
    const int row0 = ch * 64; const int seq0 = ch < 4 ? 0 : CTX, seq1 = ch < 4 ? CTX : MR;
    const LAS float* WT = (const LAS float*)(lds + L_WT);
    const int h = c >> 6;
#define CONV_LOAD(dst, tb_) do { _Pragma("unroll") for (int t_ = 0; t_ < 18; ++t_) { const int row_ = row0 + (tb_) - 1 + t_; const int rc_ = row_ < seq0 ? seq0 : (row_ >= seq1 ? seq1 - 1 : row_); dst[t_] = XBC[(size_t)rc_ * 512 + c]; } } while (0)
#define CONV_COMPUTE(src, tb_) do { float xm_ = (row0 + (tb_) > seq0) ? bf2f(src[0]) : 0.f; float x0_ = bf2f(src[1]); \
        _Pragma("unroll") for (int tt_ = 0; tt_ < 16; ++tt_) { const int t = (tb_) + tt_; \
            const float xp_ = (row0 + t + 1 < seq1) ? bf2f(src[tt_ + 2]) : 0.f; \
            const float v_ = w0 * xm_ + w1 * x0_ + w2 * xp_ + b; const float s = siluf(v_); \
            if (MODE == 0) XACT[(size_t)(row0 + t) * 512 + c] = (bf16)f2bf(s); \
            if (c < 256) { \
                if (MODE == 0) { *(LAS bf16*)(lds + L_X0 + t * XST + c * 2) = (bf16)f2bf(s * WT[h * 64 + t]); *(LAS bf16*)(lds + L_X1 + t * XST + c * 2) = (bf16)f2bf(s * WT[(4 + h) * 64 + t]); } \
                else *(LAS bf16*)(lds + L_X0 + t * XST + c * 2) = (bf16)f2bf(s); \
            } else if (c < 384) *(LAS bf16*)(lds + L_B + t * BST + (c - 256) * 2) = (bf16)f2bf(s); \
            else if (MODE == 1) *(LAS bf16*)(lds + L_C + t * BST + (c - 384) * 2) = (bf16)f2bf(s); \
            xm_ = x0_; x0_ = xp_; } } while (0)
    unsigned short xa[18], xb[18];
    CONV_LOAD(xa, 0);
#pragma unroll 1
    for (int tb = 0; tb < 64; tb += 32) {
        CONV_LOAD(xb, tb + 16);
        CONV_COMPUTE(xa, tb);
        { const int tn = tb + 32 < 64 ? tb + 32 : 0; CONV_LOAD(xa, tn); }
        CONV_COMPUTE(xb, tb + 16);
    }
#undef CONV_LOAD
#undef CONV_COMPUTE
}

__device__ __forceinline__ void ssd_states_item(const PA& A, int layer, int ch, LAS unsigned char* lds) {
    const int tid = lt_tid(), lane = tid & 63, r = lane & 31, hi = lane >> 5;
    const int w = __builtin_amdgcn_readfirstlane(tid >> 6);
    const int i16 = lane & 15, q4 = i16 >> 2, p4 = i16 & 3, blk = (lane >> 4) & 1;
    __syncthreads();
    const float dec = ssd_scan_dt(A, layer, ch, lds, w, lane);
    if (lane == 0) ((float*)(A.ws + OFF_SDEC))[ch * 8 + w] = dec;
    __syncthreads();
    ssd_conv<0>(A, layer, ch, lds, tid);
    __syncthreads();
    const int dir = w >> 2, h = w & 3, g = h >> 1;
    const LAS unsigned char* XW = lds + (dir ? L_X1 : L_X0); const LAS unsigned char* BS = lds + L_B;
    f32x16 acc[2][2];
#pragma unroll
    for (int a = 0; a < 2; ++a)
#pragma unroll
        for (int b = 0; b < 2; ++b)
#pragma unroll
            for (int i = 0; i < 16; ++i) acc[a][b][i] = 0.f;
#pragma unroll
    for (int ks = 0; ks < 4; ++ks) {
        bf16x8 af[2], bfr[2];
#pragma unroll
        for (int pt = 0; pt < 2; ++pt) { const LAS unsigned char* p = XW + (16 * ks + 8 * hi + q4) * XST + (h * 64 + 32 * pt + 16 * blk) * 2 + 8 * p4; af[pt] = cat8(vtr(p), vtr(p + 4 * XST)); }
#pragma unroll
        for (int nt = 0; nt < 2; ++nt) { const LAS unsigned char* p = BS + (16 * ks + 8 * hi + q4) * BST + (g * 64 + 32 * nt + 16 * blk) * 2 + 8 * p4; bfr[nt] = cat8(vtr(p), vtr(p + 4 * BST)); }
#pragma unroll
        for (int pt = 0; pt < 2; ++pt)
#pragma unroll
            for (int nt = 0; nt < 2; ++nt) acc[pt][nt] = MFMA32(af[pt], bfr[nt], acc[pt][nt]);
    }
    float* S = (float*)(A.ws + OFF_SST) + (size_t)ch * 32768 + dir * 16384 + h * 4096;
#pragma unroll
    for (int pt = 0; pt < 2; ++pt)
#pragma unroll
        for (int nt = 0; nt < 2; ++nt)
#pragma unroll
            for (int i = 0; i < 16; ++i) S[(32 * pt + crow(i, hi)) * 64 + 32 * nt + r] = acc[pt][nt][i];
}

__device__ __forceinline__ void ssd_out_item(const PA& A, int layer, int ch, LAS unsigned char* lds) {
    const int tid = lt_tid(), lane = tid & 63, r = lane & 31, hi = lane >> 5;
    const int w = __builtin_amdgcn_readfirstlane(tid >> 6);
    const int i16 = lane & 15, q4 = i16 >> 2, p4 = i16 & 3, blk = (lane >> 4) & 1;
    const int h = w >> 1, lt = w & 1, g = h >> 1;
    const bf16* SE = (const bf16*)(A.ws + OFF_SENT) + (size_t)ch * 32768 + h * 4096;
    bf16x8 sef[4][2], seb[4][2];
#pragma unroll
    for (int ks = 0; ks < 4; ++ks)
#pragma unroll
        for (int pt = 0; pt < 2; ++pt) { const bf16* sp = SE + (32 * pt + r) * 64 + 16 * ks + 8 * hi; sef[ks][pt] = *(const bf16x8*)sp; seb[ks][pt] = *(const bf16x8*)(sp + 16384); }
    const bf16* ZBp = (const bf16*)(A.ws + OFF_ZB) + (size_t)(ch * 64 + 32 * lt + r) * 256 + h * 64;
    u32x2 zpre[2][4];
#pragma unroll
    for (int pt = 0; pt < 2; ++pt)
#pragma unroll
        for (int g4 = 0; g4 < 4; ++g4) zpre[pt][g4] = *(const u32x2*)(ZBp + 32 * pt + 8 * g4 + 4 * hi);
    __syncthreads();
    (void)ssd_scan_dt(A, layer, ch, lds, w, lane);
    {
        const bf16* XACT = (const bf16*)(A.ws + OFF_XACT) + (size_t)ch * 64 * 512;
        u32x4 xv[8];
#pragma unroll
        for (int k = 0; k < 8; ++k) xv[k] = *(const u32x4*)(XACT + (size_t)(tid + 512 * k) * 8);
#pragma unroll
        for (int k = 0; k < 8; ++k) { const int idx = tid + 512 * k, rw = idx >> 6, c0 = (idx & 63) * 8;
            LAS unsigned char* dst = c0 < 256 ? lds + L_X0 + rw * XST + c0 * 2 : (c0 < 384 ? lds + L_B + rw * BST + (c0 - 256) * 2 : lds + L_C + rw * BST + (c0 - 384) * 2);
            *(LAS u32x4*)dst = xv[k]; }
    }
    __syncthreads();
    const LAS unsigned char* XS = lds + L_X0; const LAS unsigned char* BS = lds + L_B; const LAS unsigned char* CS = lds + L_C;
    const LAS float* SC = (const LAS float*)(lds + L_SC); const LAS float* DT = (const LAS float*)(lds + L_DT);
    const int l = 32 * lt + r;
    bf16x8 cf[4];
#pragma unroll
    for (int ks = 0; ks < 4; ++ks) cf[ks] = *(const LAS bf16x8*)(CS + l * BST + (g * 64 + 16 * ks + 8 * hi) * 2);
    const float csl = SC[h * 64 + l], rbl = SC[(4 + h) * 64 + l];
    f32x16 yd[2];
#pragma unroll
    for (int pt = 0; pt < 2; ++pt)
#pragma unroll
        for (int i = 0; i < 16; ++i) yd[pt][i] = 0.f;
#pragma unroll
    for (int st = 0; st < 2; ++st) {
        f32x16 gt;
#pragma unroll
        for (int i = 0; i < 16; ++i) gt[i] = 0.f;
#pragma unroll
        for (int ks = 0; ks < 4; ++ks) { const bf16x8 bfr = *(const LAS bf16x8*)(BS + (32 * st + r) * BST + (g * 64 + 16 * ks + 8 * hi) * 2); gt = MFMA32(bfr, cf[ks], gt); }
#pragma unroll
        for (int i = 0; i < 16; ++i) { const int s = 32 * st + crow(i, hi);
            const float ef = (s <= l) ? __expf(csl - SC[h * 64 + s]) * DT[h * 64 + s] : 0.f;
            const float eb = (s >= l) ? __expf(rbl - SC[(4 + h) * 64 + s]) * DT[(4 + h) * 64 + s] : 0.f;
            gt[i] = gt[i] * (ef + eb); }
#pragma unroll
        for (int sp = 0; sp < 2; ++sp) { const bf16x8 mb = pack8(gt, sp);
#pragma unroll
            for (int pt = 0; pt < 2; ++pt) { const LAS unsigned char* p = XS + (32 * st + 16 * sp + 4 * hi + q4) * XST + (h * 64 + 32 * pt + 16 * blk) * 2 + 8 * p4;
                yd[pt] = MFMA32(cat8(vtr(p), vtr(p + 8 * XST)), mb, yd[pt]); } }
    }
    f32x16 yf[2], yb[2];
#pragma unroll
    for (int pt = 0; pt < 2; ++pt)
#pragma unroll
        for (int i = 0; i < 16; ++i) { yf[pt][i] = 0.f; yb[pt][i] = 0.f; }
#pragma unroll
    for (int ks = 0; ks < 4; ++ks)
#pragma unroll
        for (int pt = 0; pt < 2; ++pt) { yf[pt] = MFMA32(sef[ks][pt], cf[ks], yf[pt]); yb[pt] = MFMA32(seb[ks][pt], cf[ks], yb[pt]); }
    const float efl = __expf(csl), ebl = __expf(rbl), dsk = A.in[I_SSDD][layer * 4 + h];
    const int row = ch * 64 + l;
    float ss = 0.f;
#pragma unroll
    for (int pt = 0; pt < 2; ++pt)
#pragma unroll
        for (int g4 = 0; g4 < 4; ++g4) { const int p0 = 32 * pt + 8 * g4 + 4 * hi;
            const u32x2 xv = *(const LAS u32x2*)(XS + l * XST + (h * 64 + p0) * 2); const u32x2 zv = zpre[pt][g4];
            const float xe[4] = {bf2f(xv.x & 0xffff), bf2f(xv.x >> 16), bf2f(xv.y & 0xffff), bf2f(xv.y >> 16)};
            const float ze[4] = {bf2f(zv.x & 0xffff), bf2f(zv.x >> 16), bf2f(zv.y & 0xffff), bf2f(zv.y >> 16)};
#pragma unroll
            for (int e = 0; e < 4; ++e) { const int i = 4 * g4 + e; const float y = (yd[pt][i] + efl * yf[pt][i] + ebl * yb[pt][i] + dsk * xe[e]) * ze[e]; yd[pt][i] = y; ss += y * y; } }
    ss += __shfl_xor(ss, 32);
    LAS float* SSQ = (LAS float*)(lds + L_SSQ);
    if (hi == 0) SSQ[l * 4 + h] = ss;
    __syncthreads();
    const float tot = (SSQ[l * 4] + SSQ[l * 4 + 1]) + (SSQ[l * 4 + 2] + SSQ[l * 4 + 3]);
    const float rn = rsqrtf(tot * (1.f / 256.f) + EPS);
    const float* ng = A.in[I_SSDNORM] + layer * 256 + h * 64;
    bf16* MIX = (bf16*)(A.ws + OFF_MIX) + (size_t)row * DM + h * 64;
#pragma unroll
    for (int pt = 0; pt < 2; ++pt)
#pragma unroll
        for (int g4 = 0; g4 < 4; ++g4) { const int p0 = 32 * pt + 8 * g4 + 4 * hi; const f32x4 gv = *(const f32x4*)(ng + p0);
            u32x2 o; o.x = cvtpk(yd[pt][4 * g4] * rn * gv[0], yd[pt][4 * g4 + 1] * rn * gv[1]); o.y = cvtpk(yd[pt][4 * g4 + 2] * rn * gv[2], yd[pt][4 * g4 + 3] * rn * gv[3]);
            *(u32x2*)(MIX + p0) = o; }
}

__device__ __forceinline__ void s5_e_item(const PA& A, int layer, int ct, int g, int nh, int lane) {
    const int fr = lane & 15, kq = lane >> 4;
    const bf16* UB = (const bf16*)(A.ws + OFF_UB); const bf16* BT = (const bf16*)(A.ws + OFF_BTE + layer * SZ_BTE) + (size_t)g * 65536 + (size_t)nh * 128 * 256;
    f32x4 acc[8];
#pragma unroll
    for (int n = 0; n < 8; ++n) acc[n] = (f32x4){0.f, 0.f, 0.f, 0.f};
    const int chunk = ct * 16 + fr;
    bf16x8 a[8];
#pragma unroll
    for (int kk = 0; kk < 8; ++kk) a[kk] = *(const bf16x8*)(UB + (size_t)(chunk * 16 + 2 * kk + (kq >> 1)) * 256 + g * 16 + 8 * (kq & 1));
#pragma unroll
    for (int kk = 0; kk < 8; ++kk) {
#pragma unroll
        for (int n = 0; n < 8; ++n) { const bf16x8 b = *(const bf16x8*)(BT + (size_t)(16 * n + fr) * 256 + 32 * kk + 8 * kq); acc[n] = MFMA16(a[kk], b, acc[n]); }
    }
    float* E = (float*)(A.ws + OFF_E);
#pragma unroll
    for (int n = 0; n < 8; ++n)
#pragma unroll
        for (int i = 0; i < 4; ++i) E[(size_t)(ct * 16 + 4 * kq + i) * 4096 + g * 256 + nh * 128 + 16 * n + fr] = acc[n][i];
}
__device__ __forceinline__ float gelu_tanh(float y) { const float z = 0.7978845608028654f * (y + 0.044715f * y * y * y); const float t = 1.f - 2.f * __builtin_amdgcn_rcpf(1.f + __expf(2.f * z)); return 0.5f * y * (1.f + t); }
__device__ __forceinline__ void s5_y_item(const PA& A, int layer, int ct, int g, int nh, int lane) {
    const int fr = lane & 15, kq = lane >> 4;
    const bf16* UB = (const bf16*)(A.ws + OFF_UB); const bf16* XSB = (const bf16*)(A.ws + OFF_XS); const bf16* BT = (const bf16*)(A.ws + OFF_BTY + layer * SZ_BTY) + (size_t)g * 131072 + (size_t)nh * 128 * 512;
    f32x4 acc[8];
#pragma unroll
    for (int n = 0; n < 8; ++n) acc[n] = (f32x4){0.f, 0.f, 0.f, 0.f};
    const int chunk = ct * 16 + fr;
    bf16x8 a[16];
#pragma unroll
    for (int kk = 0; kk < 8; ++kk) a[kk] = *(const bf16x8*)(UB + (size_t)(chunk * 16 + 2 * kk + (kq >> 1)) * 256 + g * 16 + 8 * (kq & 1));
#pragma unroll
    for (int kk = 0; kk < 8; ++kk) a[8 + kk] = *(const bf16x8*)(XSB + (size_t)chunk * 4096 + g * 256 + 32 * kk + 8 * kq);
#pragma unroll
    for (int kk = 0; kk < 16; ++kk) {
#pragma unroll
        for (int n = 0; n < 8; ++n) { const bf16x8 b = *(const bf16x8*)(BT + (size_t)(16 * n + fr) * 512 + 32 * kk + 8 * kq); acc[n] = MFMA16(a[kk], b, acc[n]); }
    }
    const float dsk = A.in[I_S5D][layer * 256 + g * 16 + fr];
    bf16* YG = (bf16*)(A.ws + OFF_YG);
#pragma unroll
    for (int n = 0; n < 8; ++n)
#pragma unroll
        for (int i = 0; i < 4; ++i) { const size_t tok = (size_t)(ct * 16 + 4 * kq + i) * 16 + nh * 8 + n; const size_t idx = tok * 256 + g * 16 + fr;
            const float y = acc[n][i] + dsk * bf2f(UB[idx]); YG[idx] = (bf16)f2bf(gelu_tanh(y)); }
}

constexpr int S5E_ST = 528;
__device__ __forceinline__ void s5_e_block(const PA& A, int layer, int item, LAS unsigned char* lds) {
    const int tid = lt_tid(), lane = tid & 63, fr = lane & 15, kq = lane >> 4;
    const int wave = __builtin_amdgcn_readfirstlane(tid >> 6);
    const int combo = item < 240 ? (item >> 2) : 60 + (item - 240) / 3, ng = item < 240 ? 4 : 3, rg = item < 240 ? (item & 3) : (item - 240) % 3;
    const int g = combo & 15, nq = combo >> 4;
    const bf16* UB = (const bf16*)(A.ws + OFF_UB);
    const bf16* BT = (const bf16*)(A.ws + OFF_BTE + layer * SZ_BTE) + (size_t)g * 65536 + (size_t)nq * 64 * 256;
    __syncthreads();
    { u32x4 bv[4];
#pragma unroll
      for (int i = 0; i < 4; ++i) bv[i] = *(const u32x4*)(BT + (size_t)(tid + 512 * i) * 8);
#pragma unroll
      for (int i = 0; i < 4; ++i) { const int idx = tid + 512 * i; *(LAS u32x4*)(lds + (idx >> 5) * S5E_ST + (idx & 31) * 16) = bv[i]; } }
    __syncthreads();
    float* E = (float*)(A.ws + OFF_E);
    const int ct0 = (rg * 65) / ng, ct1 = ((rg + 1) * 65) / ng;
#pragma unroll 1
    for (int ct = ct0 + wave; ct < ct1; ct += 8) {
        const int chunk = ct * 16 + fr;
        bf16x8 a[8];
#pragma unroll
        for (int kk = 0; kk < 8; ++kk) a[kk] = *(const bf16x8*)(UB + (size_t)(chunk * 16 + 2 * kk + (kq >> 1)) * 256 + g * 16 + 8 * (kq & 1));
        f32x4 acc[4];
#pragma unroll
        for (int n = 0; n < 4; ++n) acc[n] = (f32x4){0.f, 0.f, 0.f, 0.f};
#pragma unroll
        for (int kk = 0; kk < 8; ++kk)
#pragma unroll
            for (int n = 0; n < 4; ++n) { const bf16x8 bfr = *(const LAS bf16x8*)(lds + (16 * n + fr) * S5E_ST + (32 * kk + 8 * kq) * 2); acc[n] = MFMA16(a[kk], bfr, acc[n]);
                if (n == 3 && (kk & 3) == 3) asm volatile("" ::: "memory"); }
#pragma unroll
        for (int n = 0; n < 4; ++n)
#pragma unroll
            for (int i = 0; i < 4; ++i) E[(size_t)(ct * 16 + 4 * kq + i) * 4096 + g * 256 + nq * 64 + 16 * n + fr] = acc[n][i];
    }
}

constexpr int S5B_ST = 1040;
__device__ __forceinline__ void s5_y_block(const PA& A, int layer, int item, LAS unsigned char* lds) {
    const int tid = lt_tid(), lane = tid & 63, fr = lane & 15, kq = lane >> 4;
    const int wave = __builtin_amdgcn_readfirstlane(tid >> 6);
    const int combo = item < 240 ? (item >> 2) : 60 + (item - 240) / 3, ng = item < 240 ? 4 : 3, rg = item < 240 ? (item & 3) : (item - 240) % 3;
    const int g = combo & 15, nq = combo >> 4;
    const bf16* UB = (const bf16*)(A.ws + OFF_UB); const bf16* XSB = (const bf16*)(A.ws + OFF_XS);
    const bf16* BT = (const bf16*)(A.ws + OFF_BTY + layer * SZ_BTY) + (size_t)g * 131072 + (size_t)nq * 64 * 512;
    __syncthreads();
    { u32x4 bv[8];
#pragma unroll
      for (int i = 0; i < 8; ++i) bv[i] = *(const u32x4*)(BT + (size_t)(tid + 512 * i) * 8);
#pragma unroll
      for (int i = 0; i < 8; ++i) { const int idx = tid + 512 * i; *(LAS u32x4*)(lds + (idx >> 6) * S5B_ST + (idx & 63) * 16) = bv[i]; } }
    __syncthreads();
    const float dsk = A.in[I_S5D][layer * 256 + g * 16 + fr];
    bf16* YG = (bf16*)(A.ws + OFF_YG);
    const int ct0 = (rg * 65) / ng, ct1 = ((rg + 1) * 65) / ng;
#pragma unroll 1
    for (int ct = ct0 + wave; ct < ct1; ct += 8) {
        const int chunk = ct * 16 + fr;
        bf16x8 a[16];
#pragma unroll
        for (int kk = 0; kk < 8; ++kk) a[kk] = *(const bf16x8*)(UB + (size_t)(chunk * 16 + 2 * kk + (kq >> 1)) * 256 + g * 16 + 8 * (kq & 1));
#pragma unroll
        for (int kk = 0; kk < 8; ++kk) a[8 + kk] = *(const bf16x8*)(XSB + (size_t)chunk * 4096 + g * 256 + 32 * kk + 8 * kq);
        unsigned short uv[4][4];
#pragma unroll
        for (int n = 0; n < 4; ++n)
#pragma unroll
            for (int i = 0; i < 4; ++i) uv[n][i] = UB[((size_t)(ct * 16 + 4 * kq + i) * 16 + nq * 4 + n) * 256 + g * 16 + fr];
        f32x4 acc[4];
#pragma unroll
        for (int n = 0; n < 4; ++n) acc[n] = (f32x4){0.f, 0.f, 0.f, 0.f};
#pragma unroll
        for (int kk = 0; kk < 16; ++kk)
#pragma unroll
            for (int n = 0; n < 4; ++n) { const bf16x8 bfr = *(const LAS bf16x8*)(lds + (16 * n + fr) * S5B_ST + (32 * kk + 8 * kq) * 2); acc[n] = MFMA16(a[kk], bfr, acc[n]);
                if (n == 3 && (kk & 3) == 3) asm volatile("" ::: "memory"); }
#pragma unroll
        for (int n = 0; n < 4; ++n)
#pragma unroll
            for (int i = 0; i < 4; ++i) { const size_t tok = (size_t)(ct * 16 + 4 * kq + i) * 16 + nq * 4 + n; const size_t idx = tok * 256 + g * 16 + fr;
                const float y = acc[n][i] + dsk * bf2f(uv[n][i]); YG[idx] = (bf16)f2bf(gelu_tanh(y)); }
    }
}

__device__ __forceinline__ void phase_scan(const PA& A, int layer, LAS unsigned char* lds) {
    const int tid = lt_tid(), lane = tid & 63;
    const int w = __builtin_amdgcn_readfirstlane(tid >> 6);
    LAS float* SG = (LAS float*)lds;
    const int sbid = lt_bid(), sgrid = lt_grid();
    const bool balanced = (sgrid == 256);
    for (int ti = 0; ti < 3; ++ti) {
        int task;
        if (balanced) {
            if (sbid < 32) { if (ti == 0) task = sbid; else break; }
            else { const int q = sbid - 32;
                const int st = q + 224 * ti; if (st >= 512) break; task = 32 + st; }
        } else { task = sbid + ti * sgrid; if (task >= 544) break; }
        __syncthreads();
        if (task >= 32) {
            const int idx = (task - 32) * 64 + lane; const int dir = idx >> 14, h = (idx >> 12) & 3;
            const float* SST = (const float*)(A.ws + OFF_SST) + idx; const float* SDEC = (const float*)(A.ws + OFF_SDEC) + dir * 4 + h; bf16* SENT = (bf16*)(A.ws + OFF_SENT) + idx;
            const int j0 = w * 33, nj = (j0 + 33 <= NCH) ? 33 : NCH - j0;
            float s = 0.f, dp = 1.f;
#pragma unroll 1
            for (int jb = 0; jb < 33; jb += 11) {
                float d[11], v[11];
#pragma unroll
                for (int q = 0; q < 11; ++q) { const int j = j0 + jb + q; const int jc = j < NCH ? j : NCH - 1; const int c = dir ? (jc < 4 ? 3 - jc : 263 - jc) : jc; d[q] = SDEC[c * 8]; v[q] = SST[(size_t)c * 32768]; }
#pragma unroll
                for (int q = 0; q < 11; ++q) if (jb + q < nj) { s = s * d[q] + v[q]; dp *= d[q]; }
            }
            SG[(w * 4 + 0) * 64 + lane] = s; SG[(w * 4 + 1) * 64 + lane] = dp;
            __syncthreads();
            float cin = 0.f;
            for (int k = 0; k < w; ++k) cin = cin * SG[(k * 4 + 1) * 64 + lane] + SG[(k * 4 + 0) * 64 + lane];
            s = cin;
#pragma unroll 1
            for (int jb = 0; jb < 33; jb += 11) {
                float d[11], v[11];
#pragma unroll
                for (int q = 0; q < 11; ++q) { const int j = j0 + jb + q; const int jc = j < NCH ? j : NCH - 1; const int c = dir ? (jc < 4 ? 3 - jc : 263 - jc) : jc; d[q] = SDEC[c * 8]; v[q] = SST[(size_t)c * 32768]; }
#pragma unroll
                for (int q = 0; q < 11; ++q) if (jb + q < nj) { const int j = j0 + jb + q; const int c = dir ? (j < 4 ? 3 - j : 263 - j) : j; SENT[(size_t)c * 32768] = (bf16)f2bf(s); s = s * d[q] + v[q]; }
            }
        } else {
            const int e = task, dir = e >> 4, g = e & 15;
            const float* lt = (const float*)(A.ws + OFF_LAMT) + ((size_t)((layer * 2 + dir) * 16 + g) * 64 + lane) * 2;
            const float lr = lt[0], li = lt[1];
            const size_t eo = (size_t)g * 256 + dir * 128 + lane;
            const float* E = (const float*)(A.ws + OFF_E) + eo; bf16* XSB = (bf16*)(A.ws + OFF_XS) + eo;
            const int j0 = w * 130;
            float sr = 0.f, si = 0.f, dr = 1.f, di = 0.f;
#pragma unroll 1
            for (int jb = 0; jb < 130; jb += 13) {
                float er[13], ei[13];
#pragma unroll
                for (int q = 0; q < 13; ++q) { const int j = j0 + jb + q; const int c = dir ? (j < 16 ? 15 - j : 1055 - j) : j; er[q] = E[(size_t)c * 4096]; ei[q] = E[(size_t)c * 4096 + 64]; }
#pragma unroll
                for (int q = 0; q < 13; ++q) { const float tr = lr * sr - li * si + er[q]; si = lr * si + li * sr + ei[q]; sr = tr;
                    const float t2 = lr * dr - li * di; di = lr * di + li * dr; dr = t2; }
            }
            SG[(w * 4 + 0) * 64 + lane] = sr; SG[(w * 4 + 1) * 64 + lane] = si; SG[(w * 4 + 2) * 64 + lane] = dr; SG[(w * 4 + 3) * 64 + lane] = di;
            __syncthreads();
            float cr = 0.f, ci = 0.f;
            for (int k = 0; k < w; ++k) { const float pr = SG[(k * 4 + 2) * 64 + lane], pi = SG[(k * 4 + 3) * 64 + lane];
                const float tr = pr * cr - pi * ci + SG[(k * 4 + 0) * 64 + lane]; ci = pr * ci + pi * cr + SG[(k * 4 + 1) * 64 + lane]; cr = tr; }
            sr = cr; si = ci;
#pragma unroll 1
            for (int jb = 0; jb < 130; jb += 13) {
                float er[13], ei[13];
#pragma unroll
                for (int q = 0; q < 13; ++q) { const int j = j0 + jb + q; const int c = dir ? (j < 16 ? 15 - j : 1055 - j) : j; er[q] = E[(size_t)c * 4096]; ei[q] = E[(size_t)c * 4096 + 64]; }
#pragma unroll
                for (int q = 0; q < 13; ++q) { const int j = j0 + jb + q; const int c = dir ? (j < 16 ? 15 - j : 1055 - j) : j;
                    XSB[(size_t)c * 4096] = (bf16)f2bf(sr); XSB[(size_t)c * 4096 + 64] = (bf16)f2bf(si);
                    const float tr = lr * sr - li * si + er[q]; si = lr * si + li * sr + ei[q]; sr = tr; }
            }
        }
    }
}

#ifndef R_ATT
#define R_ATT 1
#endif
#ifndef R_SSM
#define R_SSM 1
#endif
#ifndef R_SSMA
#define R_SSMA R_SSM
#endif
#ifndef R_SCAN
#define R_SCAN R_SSM
#endif
#ifndef R_SSMC
#define R_SSMC R_SSM
#endif
#ifndef R_GRES
#define R_GRES 1
#endif
#ifndef R_GLU
#define R_GLU 1
#endif
#ifndef R_SSDC
#define R_SSDC 1
#endif
#ifndef R_S5C
#define R_S5C 1
#endif
#ifndef R_GIN
#define R_GIN 1
#endif
#ifndef R_GFFN
#define R_GFFN 1
#endif
#ifndef R_NORM
#define R_NORM 1
#endif
#ifndef R_SETUP
#define R_SETUP 1
#endif
#define REPL(n) _Pragma("unroll 1") for (int rr_ = 0; rr_ < (n); ++rr_)
#ifndef XSYNC
#define XSYNC 0
#endif
#ifndef PHSEL
#define PHSEL 0xffff
#endif
constexpr int N_PHASES = 2 + 10 * DEPTH;
__global__ void __launch_bounds__(NTHREADS, 2) fwd_megakernel(Args KA) {
    extern __shared__ __attribute__((aligned(16))) unsigned char lds_raw[];
    LAS unsigned char* lds = (LAS unsigned char*)lds_raw;
    cg::grid_group grid = cg::this_grid();
    if (threadIdx.x < 8) ((LAS unsigned*)(lds + 131072 + 64))[threadIdx.x] = 0u;
    __syncthreads();
    XcdBarrier xbar = xcd_barrier_post((unsigned*)(KA.ws + OFF_BAR), (volatile LAS unsigned*)(lds + 131072 + 64));
#define LOAD_PA() __attribute__((address_space(4))) const unsigned char* kp = (__attribute__((address_space(4))) const unsigned char*)__builtin_amdgcn_kernarg_segment_ptr(); asm volatile("" : "+s"(kp)); \
        PA A; A.in = (in_tab_t)kp; A.out = *(fpp_t)(kp + 264); A.ws = *(ucpp_t)(kp + 272)
#define XBAR() do { XcdBarrier xb2 = xbar; asm volatile("" : "+s"(xb2.bar)); xcd_barrier(xb2); } while (0)
    int ph = KA.ph_lo;
    if (ph == 0 && ph < KA.ph_hi) { LOAD_PA(); if (PHSEL & 1) REPL(R_SETUP) phase_setup1(A, lds); if (ph + 1 < KA.ph_hi) { if (KA.ph_lo < 0) grid.sync(); else XBAR(); } ++ph; }
    if (ph == 1 && ph < KA.ph_hi) { LOAD_PA(); if (PHSEL & 2) REPL(R_SETUP) phase_setup2(A); if (ph + 1 < KA.ph_hi) XBAR(); ++ph; }
#pragma unroll 1
    for (; ph < KA.ph_hi; ++ph) {
        LOAD_PA();
        unsigned char* ws = A.ws;
        const int G = lt_grid(), bid = lt_bid();
        const int tid = lt_tid(), lane = tid & 63, wave = tid >> 6;
        {
            const int L = (ph - 2) / 10, k = (ph - 2) % 10;
            const float* modl = (const float*)(ws + OFF_MOD) + (size_t)(L * 2) * 6144; const float* modc = modl + 6144;
            if (k == 0) { if (PHSEL & 4) REPL(R_NORM) phase_modnorm(A, L, 0); }
            else if (k == 1) {
                pg8::Gemm g{(const bf16*)(ws + OFF_H), (const bf16*)(ws + OFF_WIN + L * SZ_WIN), MR, NIN, DM}; pg8::StaticOrder S; S.init(MR, NIN, G, bid); S.nkt = DM / 64;
                EpiIn E{(bf16*)(ws + OFF_ZB), (bf16*)(ws + OFF_XBC), (bf16*)(ws + OFF_UB), (bf16*)(ws + OFF_QB), (bf16*)(ws + OFF_KB), (bf16*)(ws + OFF_VB), (float*)(ws + OFF_DTB),
                        A.in[I_QN] + L * 32, A.in[I_KN] + L * 32, A.in[I_DTBIAS] + L * 8, (const float*)(ws + OFF_ROPE)};
                if (PHSEL & 8) REPL(R_GIN) pg8::gemm_phase<EpiIn, pg8::StaticOrder, true, true>(lds, g, S, E);
            } else if (k == 2) {
                REPL(R_SSMA) {
                    if (bid < NCH) ssd_states_item(A, L, bid, lds);
                    if (bid + G < NCH) ssd_states_item(A, L, bid + G, lds);
                    else { const int nb = G - (NCH - G), b2 = bid - (NCH - G);
                        if (nb >= 252) { if (b2 < 252) s5_e_block(A, L, b2, lds); }
                        else for (int it = b2 * 8 + wave; it < 65 * 32; it += nb * 8) s5_e_item(A, L, it >> 5, (it >> 1) & 15, it & 1, lane); }
                }
            } else if (k == 3) { if (PHSEL & 64) REPL(R_SCAN) phase_scan(A, L, lds); }
            else if (k == 4) {
                REPL(R_SSMC) {
                    REPL(R_SSDC) { if (bid < NCH) ssd_out_item(A, L, bid, lds);
                    if (bid + G < NCH) ssd_out_item(A, L, bid + G, lds); }
                    if (!(bid + G < NCH)) REPL(R_S5C) { const int nb = G - (NCH - G), b2 = bid - (NCH - G);
                        if (nb >= 252) { if (b2 < 252) s5_y_block(A, L, b2, lds); }
                        else for (int it = b2 * 8 + wave; it < 65 * 32; it += nb * 8) s5_y_item(A, L, it >> 5, (it >> 1) & 15, it & 1, lane); }
                }
            } else if (k == 5) {
                if (bid >= G - 65) {
                    pg8::Gemm g{(const bf16*)(ws + OFF_YG), (const bf16*)(ws + OFF_GLU + L * SZ_GLU), MR, 256, 256}; pg8::StaticOrder S; S.init(MR, 256, 65, bid - (G - 65)); S.nkt = 4;
                    EpiGlu E{(const bf16*)(ws + OFF_YG), (bf16*)(ws + OFF_MIX), A.in[I_GLUB] + L * 256};
                    if (PHSEL & 512) REPL(R_GLU) pg8::gemm_phase<EpiGlu, pg8::StaticOrder, true, true>(lds, g, S, E);
                }
                if (PHSEL & 1024) REPL(R_ATT) phase_attn(A, L, lds);
            } else if (k == 6) {
                pg8::Gemm g{(const bf16*)(ws + OFF_MIX), (const bf16*)(ws + OFF_WOUT + L * SZ_WOUT), MR, DM, DM}; SplitOrder S; S.init(G, bid, DM / 64, 4, L < DEPTH - 1);
                EpiRes E{A.out, (float*)(ws + OFF_XC), modl + 2 * DM, modc + 2 * DM, 1.0f / R_GRES};
                if (PHSEL & 2048) REPL(R_GRES) pg8::gemm_phase<EpiRes, SplitOrder, true, true>(lds, g, S, E);
            } else if (k == 7) { if (PHSEL & 4) REPL(R_NORM) phase_modnorm(A, L, 1); }
            else if (k == 8) {
                pg8::Gemm g{(const bf16*)(ws + OFF_H), (const bf16*)(ws + OFF_W13 + L * SZ_W13), MR, NFF2, DM}; pg8::StaticOrder S; S.init(MR, NFF2, G, bid); S.nkt = DM / 64;
                EpiFfn E{(bf16*)(ws + OFF_FFU)};
                if (PHSEL & 4096) REPL(R_GFFN) pg8::gemm_phase<EpiFfn, pg8::StaticOrder, true, true>(lds, g, S, E);
            } else {
                pg8::Gemm g{(const bf16*)(ws + OFF_FFU), (const bf16*)(ws + OFF_W2 + L * SZ_W2), MR, DM, DFF}; SplitOrder S; S.init(G, bid, DFF / 64, 11, L < DEPTH - 1);
                EpiRes E{A.out, (float*)(ws + OFF_XC), modl + 5 * DM, modc + 5 * DM, 1.0f / R_GRES};
                if (PHSEL & 2048) REPL(R_GRES) pg8::gemm_phase<EpiRes, SplitOrder, true, true>(lds, g, S, E);
            }
        }
        for (int xs = 0; xs < XSYNC; ++xs) XBAR();
        if (ph + 1 < KA.ph_hi) XBAR();
    }
}

#ifndef N_LAUNCH_SPLIT
#define N_LAUNCH_SPLIT 0
#endif
static_assert(offsetof(Args, out) == 264 && offsetof(Args, ws) == 272, "Args layout");
extern "C" void kernel_launch(void* const* d_in, const int* in_sizes, int n_in, void* d_out, int out_size, void* d_ws, size_t ws_size, hipStream_t stream) {
    static int grid = 0;
    if (grid == 0) {
        if (n_in != 33 || out_size != SEQ * DM || ws_size < WS_END) { fprintf(stderr, "kernel_launch: unexpected shapes: n_in %d out %d ws %zu (need %zu)\n", n_in, out_size, ws_size, (size_t)WS_END); grid = -1; return; }
        int dev = 0, cus = 0, per_cu = 0;
        (void)hipGetDevice(&dev); (void)hipDeviceGetAttribute(&cus, hipDeviceAttributeMultiprocessorCount, dev);
        (void)hipFuncSetAttribute((const void*)fwd_megakernel, hipFuncAttributeMaxDynamicSharedMemorySize, LDS_BYTES);
        (void)hipOccupancyMaxActiveBlocksPerMultiprocessor(&per_cu, (const void*)fwd_megakernel, NTHREADS, LDS_BYTES);
        fprintf(stderr, "kernel_launch: cus %d, blocks/CU %d, ws %zu need %zu\n", cus, per_cu, ws_size, (size_t)WS_END);
        (void)hipGetLastError();
        grid = cus > 0 ? cus : 256;
    }
    if (grid < 0) return;
    (void)hipMemsetAsync((unsigned char*)d_ws + OFF_BAR, 0, BAR_BYTES, stream);
    Args a{};
    for (int i = 0; i < 33; ++i) a.in[i] = (const float*)d_in[i];
    a.out = (float*)d_out; a.ws = (unsigned char*)d_ws;
#if N_LAUNCH_SPLIT
    for (int ph = 0; ph < N_PHASES; ++ph) { a.ph_lo = ph; a.ph_hi = ph + 1; void* args[] = {&a};
        hipError_t e = hipLaunchCooperativeKernel((const void*)fwd_megakernel, dim3(grid), dim3(NTHREADS), args, LDS_BYTES, stream);
        if (e != hipSuccess) { fprintf(stderr, "cooperative launch failed: %s\n", hipGetErrorString(e)); break; } }
#else
    a.ph_lo = 0; a.ph_hi = N_PHASES; void* args[] = {&a};
    hipError_t e = hipLaunchCooperativeKernel((const void*)fwd_megakernel, dim3(grid), dim3(NTHREADS), args, LDS_BYTES, stream);
    if (e != hipSuccess) fprintf(stderr, "cooperative launch failed: %s (grid %d)\n", hipGetErrorString(e), grid);
#endif
}
```
